# Optimizing an MI355X kernel written in HIP

```python
import math
import jax, jax.numpy as jnp
from jax import lax
import numpy as np

D_MODEL = 1024
BATCH = 2
SEQ = 8192
DEPTH = 1

PLE_DIM = 256
ROPE_THETA = 10000.0
EPS = 1e-6
BLOCK = 128
NEG_INF = -1e30

SWA_HEAD_DIM = 64
SWA_HEADS = D_MODEL // SWA_HEAD_DIM
SWA_KV_HEADS = SWA_HEADS // 8
SWA_WINDOW = 128

MLA_NOPE_DIM = 128
MLA_ROPE_DIM = 64
MLA_V_DIM = 128
MLA_HEADS = D_MODEL // MLA_V_DIM
MLA_Q_RANK = 256
MLA_KV_RANK = 128

N_GROUPS = 4
EXPERTS_PER_GROUP = 4
N_EXPERTS = N_GROUPS * EXPERTS_PER_GROUP
EXPERT_TOP_K = 2
D_EXPERT = 256

IN_SIZES = (SWA_HEADS * SWA_HEAD_DIM, SWA_KV_HEADS * SWA_HEAD_DIM, SWA_KV_HEADS * SWA_HEAD_DIM,
            MLA_Q_RANK, MLA_KV_RANK, MLA_ROPE_DIM, D_MODEL, D_MODEL)
D_IN = sum(IN_SIZES)

kernel_name = "hybrid_swa_mla_hier_moe_block"


def rmsnorm(x, g):
    xf = x.astype(jnp.float32)
    r = lax.rsqrt(jnp.mean(xf * xf, axis=-1, keepdims=True) + EPS)
    return (xf * r * g.astype(jnp.float32)).astype(x.dtype)


def rope_tables(seq, dim, dtype):
    pos = jnp.arange(seq, dtype=jnp.float32)
    inv = ROPE_THETA ** (-jnp.arange(0, dim, 2, dtype=jnp.float32) / dim)
    ang = pos[:, None] * inv[None, :]
    return jnp.cos(ang).astype(dtype), jnp.sin(ang).astype(dtype)


def apply_rope(x, cos, sin):
    x1, x2 = jnp.split(x, 2, axis=-1)
    c, s = cos[:, None, :], sin[:, None, :]
    return jnp.concatenate([x1 * c - x2 * s, x2 * c + x1 * s], axis=-1)


def split_points():
    points, acc = [], 0
    for size in IN_SIZES[:-1]:
        acc += size
        points.append(acc)
    return points


def sliding_window_attention(q, k, v, sinks):
    B, S, HQ, d = q.shape
    HKV = k.shape[2]
    G = HQ // HKV
    nb = S // BLOCK
    qb = q.reshape(B, nb, BLOCK, HKV, G, d)
    kb = k.reshape(B, nb, BLOCK, HKV, d)
    vb = v.reshape(B, nb, BLOCK, HKV, d)
    pad = ((0, 0), (1, 0), (0, 0), (0, 0), (0, 0))
    kk = jnp.concatenate([jnp.pad(kb[:, :-1], pad), kb], axis=2)
    vv = jnp.concatenate([jnp.pad(vb[:, :-1], pad), vb], axis=2)
    s = jnp.einsum('bnqhgd,bnkhd->bnhgqk', qb, kk,
                   preferred_element_type=jnp.float32) * (1.0 / math.sqrt(d))
    qi = jnp.arange(BLOCK)[:, None]
    kj = jnp.arange(2 * BLOCK)[None, :]
    dist = BLOCK + qi - kj
    key_pos = jnp.arange(nb)[:, None, None] * BLOCK - BLOCK + kj[None]
    allowed = (dist >= 0)[None] & (dist < SWA_WINDOW)[None] & (key_pos >= 0)
    s = jnp.where(allowed[None, :, None, None], s, NEG_INF)
    sink = sinks.astype(jnp.float32).reshape(HKV, G)[None, None, :, :, None, None]
    m = jnp.maximum(jnp.max(s, axis=-1, keepdims=True), sink)
    e = jnp.exp(s - m)
    pr = e / (jnp.sum(e, axis=-1, keepdims=True) + jnp.exp(sink - m))
    o = jnp.einsum('bnhgqk,bnkhd->bnqhgd', pr.astype(v.dtype), vv)
    return o.reshape(B, S, HQ * d)


def latent_attention(q_nope, q_rope, k_nope, k_rope, v):
    B, S, H, _ = q_nope.shape
    nb = S // BLOCK
    qn = q_nope.reshape(B, nb, BLOCK, H, MLA_NOPE_DIM).transpose(1, 0, 2, 3, 4)
    qr = q_rope.reshape(B, nb, BLOCK, H, MLA_ROPE_DIM).transpose(1, 0, 2, 3, 4)
    starts = jnp.arange(nb, dtype=jnp.int32) * BLOCK
    kpos = jnp.arange(S, dtype=jnp.int32)
    scale = 1.0 / math.sqrt(MLA_NOPE_DIM + MLA_ROPE_DIM)

    def one_block(args):
        qn_b, qr_b, start = args
        s = (jnp.einsum('bqhd,bkhd->bhqk', qn_b, k_nope, preferred_element_type=jnp.float32)
             + jnp.einsum('bqhr,bkr->bhqk', qr_b, k_rope, preferred_element_type=jnp.float32)) * scale
        qpos = start + jnp.arange(BLOCK, dtype=jnp.int32)
        s = jnp.where(kpos[None, :] <= qpos[:, None], s, NEG_INF)
        pr = jax.nn.softmax(s, axis=-1)
        return jnp.einsum('bhqk,bkhd->bqhd', pr.astype(v.dtype), v)

    o = lax.map(one_block, (qn, qr, starts))
    return o.transpose(1, 0, 2, 3, 4).reshape(B, S, H * MLA_V_DIM)


def hybrid_mixer(xn, w_in, swa_sinks, mla_g_q, mla_w_uq, mla_g_kv, mla_w_ukv, w_out,
                 cos_a, sin_a, cos_b, sin_b):
    B, S, _ = xn.shape
    proj = xn @ w_in
    q_a, k_a, v_a, c_q, c_kv, k_rope, gate_a, gate_b = jnp.split(proj, split_points(), axis=-1)
    q_a = apply_rope(q_a.reshape(B, S, SWA_HEADS, SWA_HEAD_DIM), cos_a, sin_a)
    k_a = apply_rope(k_a.reshape(B, S, SWA_KV_HEADS, SWA_HEAD_DIM), cos_a, sin_a)
    v_a = v_a.reshape(B, S, SWA_KV_HEADS, SWA_HEAD_DIM)
    o_a = sliding_window_attention(q_a, k_a, v_a, swa_sinks)
    q = (rmsnorm(c_q, mla_g_q) @ mla_w_uq).reshape(B, S, MLA_HEADS, MLA_NOPE_DIM + MLA_ROPE_DIM)
    q_nope, q_rope = jnp.split(q, [MLA_NOPE_DIM], axis=-1)
    q_rope = apply_rope(q_rope, cos_b, sin_b)
    kv = (rmsnorm(c_kv, mla_g_kv) @ mla_w_ukv).reshape(B, S, MLA_HEADS, MLA_NOPE_DIM + MLA_V_DIM)
    k_nope, v_b = jnp.split(kv, [MLA_NOPE_DIM], axis=-1)
    k_rope = apply_rope(k_rope[:, :, None, :], cos_b, sin_b)[:, :, 0, :]
    o_b = latent_attention(q_nope, q_rope, k_nope, k_rope, v_b)
    merged = jax.nn.sigmoid(gate_a) * o_a + jax.nn.sigmoid(gate_b) * o_b
    return merged @ w_out


def hierarchical_moe(xn, w_router_group, b_router_group, w_router_expert, b_router_expert,
                     w_expert_in, w_expert_out):
    B, S, D = xn.shape
    T = B * S
    xt = xn.reshape(T, D)
    g_prob = jax.nn.softmax((xt @ w_router_group + b_router_group).astype(jnp.float32), axis=-1)
    gidx = jnp.argmax(g_prob, axis=-1)
    g_w = jnp.take_along_axis(g_prob, gidx[:, None], axis=-1)
    e_logits = (xt @ w_router_expert + b_router_expert).astype(jnp.float32)
    e_logits = e_logits.reshape(T, N_GROUPS, EXPERTS_PER_GROUP)
    e_sel = jnp.take_along_axis(e_logits, gidx[:, None, None], axis=1)[:, 0]
    e_prob = jax.nn.softmax(e_sel, axis=-1)
    top_v, top_i = lax.top_k(e_prob, EXPERT_TOP_K)
    top_v = top_v / jnp.sum(top_v, axis=-1, keepdims=True)
    w_group = jnp.sum(jax.nn.one_hot(top_i, EXPERTS_PER_GROUP, dtype=jnp.float32) * top_v[..., None], axis=1)
    combine = (jax.nn.one_hot(gidx, N_GROUPS, dtype=jnp.float32)[:, :, None]
               * w_group[:, None, :] * g_w[:, :, None]).reshape(T, N_EXPERTS)
    hid = jnp.einsum('td,edf->tef', xt, w_expert_in)
    gate, up = jnp.split(hid, 2, axis=-1)
    act = jax.nn.silu(gate) * up * combine[..., None].astype(xn.dtype)
    y = jnp.einsum('tef,efd->td', act, w_expert_out)
    return y.reshape(B, S, D)


def setup_inputs(seed: int = 0) -> dict:
    key = jax.random.key(seed)
    ks = jax.random.split(key, 24)

    def nrm(k, shape, scale):
        return jax.random.normal(k, shape, jnp.float32) * scale

    def gain(k, shape):
        return 1.0 + 0.05 * jax.random.normal(k, shape, jnp.float32)

    L = DEPTH
    return {
        "x": nrm(ks[0], (BATCH, SEQ, D_MODEL), 1.0),
        "p": nrm(ks[1], (DEPTH, BATCH, SEQ, PLE_DIM), 1.0),
        "g_mix": gain(ks[2], (L, D_MODEL)),
        "w_in": nrm(ks[3], (L, D_MODEL, D_IN), D_MODEL ** -0.5),
        "swa_sinks": nrm(ks[4], (L, SWA_HEADS), 0.5),
        "mla_g_q": gain(ks[5], (L, MLA_Q_RANK)),
        "mla_w_uq": nrm(ks[6], (L, MLA_Q_RANK, MLA_HEADS * (MLA_NOPE_DIM + MLA_ROPE_DIM)), MLA_Q_RANK ** -0.5),
        "mla_g_kv": gain(ks[7], (L, MLA_KV_RANK)),
        "mla_w_ukv": nrm(ks[8], (L, MLA_KV_RANK, MLA_HEADS * (MLA_NOPE_DIM + MLA_V_DIM)), MLA_KV_RANK ** -0.5),
        "w_out": nrm(ks[9], (L, D_MODEL, D_MODEL), D_MODEL ** -0.5),
        "g_ffn": gain(ks[10], (L, D_MODEL)),
        "w_router_group": nrm(ks[11], (L, D_MODEL, N_GROUPS), D_MODEL ** -0.5),
        "b_router_group": nrm(ks[12], (L, N_GROUPS), 0.01),
        "w_router_expert": nrm(ks[13], (L, D_MODEL, N_EXPERTS), D_MODEL ** -0.5),
        "b_router_expert": nrm(ks[14], (L, N_EXPERTS), 0.01),
        "w_expert_in": nrm(ks[15], (L, N_EXPERTS, D_MODEL, 2 * D_EXPERT), D_MODEL ** -0.5),
        "w_expert_out": nrm(ks[16], (L, N_EXPERTS, D_EXPERT, D_MODEL), D_EXPERT ** -0.5),
        "g_ple": gain(ks[17], (L, D_MODEL)),
        "w_ple_gate": nrm(ks[18], (L, D_MODEL, D_MODEL), D_MODEL ** -0.5),
        "w_ple_proj": nrm(ks[19], (L, PLE_DIM, D_MODEL), PLE_DIM ** -0.5),
        "g_final": gain(ks[20], (D_MODEL,)),
    }


def reference(x, p, g_mix, w_in, swa_sinks, mla_g_q, mla_w_uq, mla_g_kv, mla_w_ukv, w_out,
              g_ffn, w_router_group, b_router_group, w_router_expert, b_router_expert,
              w_expert_in, w_expert_out, g_ple, w_ple_gate, w_ple_proj, g_final):
    S = x.shape[1]
    cos_a, sin_a = rope_tables(S, SWA_HEAD_DIM, x.dtype)
    cos_b, sin_b = rope_tables(S, MLA_ROPE_DIM, x.dtype)
    h = x
    for i in range(DEPTH):
        h = h + hybrid_mixer(rmsnorm(h, g_mix[i]), w_in[i], swa_sinks[i], mla_g_q[i], mla_w_uq[i],
                             mla_g_kv[i], mla_w_ukv[i], w_out[i], cos_a, sin_a, cos_b, sin_b)
        h = h + hierarchical_moe(rmsnorm(h, g_ffn[i]), w_router_group[i], b_router_group[i],
                                 w_router_expert[i], b_router_expert[i], w_expert_in[i], w_expert_out[i])
        ple_gate = jax.nn.sigmoid(rmsnorm(h, g_ple[i]) @ w_ple_gate[i])
        h = h + ple_gate * (p[i] @ w_ple_proj[i])
    return rmsnorm(h, g_final)
```

```cpp
#include <hip/hip_runtime.h>
#include <hip/hip_bf16.h>
#include <cstdio>
#include <cstdint>

#ifndef MK_ONE_LAUNCH
#define MK_ONE_LAUNCH 1
#endif

#define LAS __attribute__((address_space(3)))
#define GAS __attribute__((address_space(1)))
typedef unsigned short bf16_t;
typedef short bf16x8 __attribute__((ext_vector_type(8)));
typedef short s16x4 __attribute__((ext_vector_type(4)));
typedef float f32x2 __attribute__((ext_vector_type(2)));
typedef float f32x4 __attribute__((ext_vector_type(4)));
typedef float f32x16 __attribute__((ext_vector_type(16)));
typedef unsigned u32x2 __attribute__((ext_vector_type(2)));
typedef unsigned u32x4 __attribute__((ext_vector_type(4)));

constexpr int T_TOK = 16384, SEQ = 8192, DM = 1024;
constexpr int N1 = 1792;
constexpr int NGATE = 2048;
constexpr int QW = 1536, KVW = 2048;
constexpr int NEXP = 16, DEXP = 256;
constexpr int MAXTILES = 144, MAXSLOTS = MAXTILES * 256;
constexpr float EPS = 1e-6f;
constexpr float LOG2E = 1.4426950408889634f;
constexpr float C2SWA = 0.125f * LOG2E;
constexpr float C2MLA = 0.07216878364870322f * LOG2E;

__device__ __forceinline__ unsigned cvt_pk_bf16(float lo, float hi) { unsigned r; asm volatile("v_cvt_pk_bf16_f32 %0, %1, %2" : "=v"(r) : "v"(lo), "v"(hi)); return r; }
__device__ __forceinline__ float bf_lo(unsigned w) { return __uint_as_float(w << 16); }
__device__ __forceinline__ float bf_hi(unsigned w) { return __uint_as_float(w & 0xffff0000u); }
__device__ __forceinline__ float fsigmoid(float x) { return __builtin_amdgcn_rcpf(1.f + __builtin_amdgcn_exp2f(-x * LOG2E)); }
__device__ __forceinline__ int opaque_tid() { int t = threadIdx.x; asm volatile("" : "+v"(t)); return t; }
__device__ __forceinline__ float wave_sum(float v) {
#pragma unroll
    for (int o = 1; o < 64; o <<= 1) v += __shfl_xor(v, o);
    return v;
}

namespace pg8 {
constexpr int BM = 256, BK = 64, HALF = 128, HTB = HALF * BK * 2, STAGE_BYTES = 8 * HTB, NXCD = 8, WGM = 8;
__host__ __device__ __forceinline__ int lds_byte(int r, int c) { const int st = (r >> 4) * 2 + (c >> 5), rr = r & 15, cc = c & 31, ob = rr * 64 + cc * 2; return st * 1024 + (ob ^ (((ob >> 9) & 1) << 5)); }
__host__ __device__ __forceinline__ void stage_rc(int b, int& R, int& C) { const int st = b / 1024, sb = b % 1024, swz = sb ^ (((sb >> 9) & 1) << 5); R = (st >> 1) * 16 + swz / 64; C = (st & 1) * 32 + (swz % 64) / 2; }
__host__ __device__ __forceinline__ int perm32(int rho) { const int n = rho >> 4, i = rho & 15; return 8 * (i >> 2) + 4 * n + (i & 3); }

struct Unit { int pm, pn, pb; };
struct Gemm { const bf16_t* A; const bf16_t* Bt; int K; };

struct StaticOrder {
    int nM, nN, nwg, G, c;
    __device__ __forceinline__ void init(int M, int N, int G_, int c_) { nM = M / BM; nN = N / BM; nwg = nM * nN; G = G_; c = c_; }
    __device__ __forceinline__ bool next(int i, Unit& u) const {
        const long L = (long)i * G + c; if (L >= nwg) return false;
        int wgid = (int)L; { const int q = nwg / NXCD, r = nwg % NXCD, xcd = wgid % NXCD, off = wgid / NXCD; wgid = (xcd < r ? xcd * (q + 1) : r * (q + 1) + (xcd - r) * q) + off; }
        const int nig = WGM * nN, gid = wgid / nig, fm = gid * WGM, gsz = (nM - fm) < WGM ? (nM - fm) : WGM;
        u.pm = fm + ((wgid % nig) % gsz); u.pn = (wgid % nig) / gsz; u.pb = u.pn; return true;
    }
};
struct GroupedOrder {
    const int* meta; int npn, G, c, ntiles;
    __device__ __forceinline__ void init(const int* meta_, int npn_, int G_, int c_) {
        meta = meta_; npn = npn_; G = G_; c = c_;
        ntiles = __builtin_amdgcn_readfirstlane(__hip_atomic_load(meta, __ATOMIC_RELAXED, __HIP_MEMORY_SCOPE_AGENT));
        if (ntiles > MAXTILES) ntiles = MAXTILES;
    }
    __device__ __forceinline__ bool next(int i, Unit& u) const {
        const int L = i * G + c; if (L >= ntiles * npn) return false;
        u.pm = L / npn; u.pn = L % npn;
        const int e = __builtin_amdgcn_readfirstlane(__hip_atomic_load(meta + 16 + u.pm, __ATOMIC_RELAXED, __HIP_MEMORY_SCOPE_AGENT));
        u.pb = e * npn + u.pn; return true;
    }
};

typedef f32x4 Acc[2][2][4][2];

template <class Epi, class Sched>
__device__ __forceinline__ void gemm_phase(LAS unsigned char* lds, const Gemm g, const Sched& S, const Epi& E) {
    const int tid = opaque_tid(), wid = __builtin_amdgcn_readfirstlane(tid >> 6), lane = tid & 63, wr = wid >> 2, wc = wid & 3, fr = lane & 15, fq = lane >> 4;
    const int K = g.K, nt = K / BK;
    unsigned voffA[2], voffB[2];
#pragma unroll
    for (int i = 0; i < 2; ++i) { int R, C; stage_rc(tid * 16 + i * 8192, R, C); const int Rb = (R & ~31) + perm32(R & 31);
        voffA[i] = (unsigned)(R * K + C) * 2u; voffB[i] = (unsigned)(Rb * K + C) * 2u; }
    const size_t kstep = (size_t)(BK * 2);
    const size_t hstep = (size_t)HALF * K * 2;
    const size_t tstep = 2 * hstep;
    const unsigned ldsw = (unsigned)wid * 1024u;
    const int aoff = lds_byte(wr * 64 + fr, fq * 8), boff = lds_byte(wc * 32 + fr, fq * 8);
#define PG8_SA(b, h) (((b) * 2 + (h)) * HTB)
#define PG8_SB(b, h) ((4 + (b) * 2 + (h)) * HTB)
#define PG8_STAGE(bufoff, gbase, voff) do { _Pragma("unroll") for (int _i = 0; _i < 2; ++_i) \
        __builtin_amdgcn_global_load_lds((const unsigned*)((const char*)(gbase) + (voff)[_i]), (LAS unsigned*)(lds + (bufoff) + ldsw + _i * 8192), 16, 0, 0); } while (0)
#define PG8_LDA(dst, b, h) do { _Pragma("unroll") for (int m = 0; m < 4; ++m) _Pragma("unroll") for (int k = 0; k < 2; ++k) dst[m][k] = *(const LAS bf16x8*)(lds + PG8_SA(b, h) + aoff + m * 2048 + k * 1024); } while (0)
#define PG8_LDB(dst, b, h) do { _Pragma("unroll") for (int n = 0; n < 2; ++n) _Pragma("unroll") for (int k = 0; k < 2; ++k) dst[n][k] = *(const LAS bf16x8*)(lds + PG8_SB(b, h) + boff + n * 2048 + k * 1024); } while (0)
#define PG8_MMA(ai, bj, At, Bt) do { __builtin_amdgcn_s_setprio(1); _Pragma("unroll") for (int m = 0; m < 4; ++m) _Pragma("unroll") for (int n = 0; n < 2; ++n) _Pragma("unroll") for (int k = 0; k < 2; ++k) \
        acc[ai][bj][m][n] = __builtin_amdgcn_mfma_f32_16x16x32_bf16(Bt[n][k], At[m][k], acc[ai][bj][m][n], 0, 0, 0); __builtin_amdgcn_s_setprio(0); } while (0)
#define PG8_WAIT_V(n) asm volatile("s_waitcnt vmcnt(" #n ")" ::: "memory")
#define PG8_WAIT_L(n) asm volatile("s_waitcnt lgkmcnt(" #n ")" ::: "memory")
#define PG8_BAR __builtin_amdgcn_s_barrier()
#define PG8_SCHED __builtin_amdgcn_sched_barrier(0)
    Unit cur, nxt; int ui = 0;
    if (!S.next(0, cur)) return;
    Acc acc;
#pragma unroll
    for (int a = 0; a < 2; ++a)
#pragma unroll
        for (int b = 0; b < 2; ++b)
#pragma unroll
            for (int m = 0; m < 4; ++m)
#pragma unroll
                for (int n = 0; n < 2; ++n) acc[a][b][m][n] = (f32x4){0.f, 0.f, 0.f, 0.f};
    bf16x8 At[4][2], B0[2][2], B1[2][2];
    const char* cA = (const char*)g.A + (size_t)cur.pm * tstep; const char* cB = (const char*)g.Bt + (size_t)cur.pb * tstep;
    PG8_STAGE(PG8_SB(0, 0), cB, voffB); PG8_STAGE(PG8_SB(0, 1), cB + hstep, voffB); PG8_STAGE(PG8_SA(0, 0), cA, voffA); PG8_STAGE(PG8_SA(0, 1), cA + hstep, voffA);
    if (wr == 1) PG8_BAR;
    PG8_WAIT_V(2); PG8_BAR;
    PG8_STAGE(PG8_SB(1, 0), cB + kstep, voffB); PG8_STAGE(PG8_SA(1, 0), cA + kstep, voffA); PG8_STAGE(PG8_SB(1, 1), cB + hstep + kstep, voffB);
    PG8_WAIT_V(6); PG8_BAR;
    for (;;) {
        const bool has_next = S.next(ui + 1, nxt);
        const char* nA = has_next ? (const char*)g.A + (size_t)nxt.pm * tstep : cA; const char* nB = has_next ? (const char*)g.Bt + (size_t)nxt.pb * tstep : cB;
        for (int t = 0; t < nt; t += 2) {
            const bool last = (t == nt - 2);
            const char* a1 = cA + (size_t)(t + 1) * kstep;
            const char* a2 = last ? nA : cA + (size_t)(t + 2) * kstep; const char* b2 = last ? nB : cB + (size_t)(t + 2) * kstep;
            const char* a3 = a2 + kstep; const char* b3 = b2 + kstep;
            PG8_LDB(B0, 0, 0); PG8_LDB(B1, 0, 1); PG8_SCHED; PG8_LDA(At, 0, 0); PG8_STAGE(PG8_SA(1, 1), a1 + hstep, voffA);
            PG8_WAIT_V(8); PG8_WAIT_L(0); PG8_BAR; PG8_MMA(0, 0, At, B0); PG8_MMA(0, 1, At, B1); PG8_BAR; PG8_SCHED;
            PG8_LDA(At, 0, 1); PG8_STAGE(PG8_SB(0, 0), b2, voffB); PG8_STAGE(PG8_SB(0, 1), b2 + hstep, voffB); PG8_STAGE(PG8_SA(0, 0), a2, voffA);
            PG8_WAIT_V(8); PG8_WAIT_L(0); PG8_BAR; PG8_MMA(1, 0, At, B0); PG8_MMA(1, 1, At, B1); PG8_BAR; PG8_SCHED;
            PG8_LDB(B0, 1, 0); PG8_LDB(B1, 1, 1); PG8_SCHED; PG8_LDA(At, 1, 0); PG8_STAGE(PG8_SA(0, 1), a2 + hstep, voffA);
            PG8_WAIT_V(8); PG8_WAIT_L(0); PG8_BAR; PG8_MMA(0, 0, At, B0); PG8_MMA(0, 1, At, B1); PG8_BAR; PG8_SCHED;
            PG8_LDA(At, 1, 1); PG8_STAGE(PG8_SB(1, 0), b3, voffB); PG8_STAGE(PG8_SB(1, 1), b3 + hstep, voffB); PG8_STAGE(PG8_SA(1, 0), a3, voffA);
            PG8_WAIT_V(8); PG8_WAIT_L(0); PG8_BAR; PG8_MMA(1, 0, At, B0); PG8_MMA(1, 1, At, B1); PG8_BAR; PG8_SCHED;
        }
        if (wr == 0) PG8_BAR;
        E(acc, cur, wr, wc, fr, fq);
        if (!has_next) break;
#pragma unroll
        for (int a = 0; a < 2; ++a)
#pragma unroll
            for (int b = 0; b < 2; ++b)
#pragma unroll
                for (int m = 0; m < 4; ++m)
#pragma unroll
                    for (int n = 0; n < 2; ++n) acc[a][b][m][n] = (f32x4){0.f, 0.f, 0.f, 0.f};
        cur = nxt; cA = nA; cB = nB; ++ui;
        if (wr == 1) PG8_BAR;
    }
    PG8_WAIT_V(0);
    PG8_BAR;
#undef PG8_SA
#undef PG8_SB
#undef PG8_STAGE
#undef PG8_LDA
#undef PG8_LDB
#undef PG8_MMA
#undef PG8_WAIT_V
#undef PG8_WAIT_L
#undef PG8_BAR
#undef PG8_SCHED
}

__device__ __forceinline__ u32x4 pack8(f32x4 a, f32x4 b) { u32x4 w; w.x = cvt_pk_bf16(a[0], a[1]); w.y = cvt_pk_bf16(a[2], a[3]); w.z = cvt_pk_bf16(b[0], b[1]); w.w = cvt_pk_bf16(b[2], b[3]); return w; }
__device__ __forceinline__ void rope8(f32x4& a, f32x4& b, const float* tabrow, int i0) {
    const f32x4 t0 = *(const f32x4*)(tabrow + 2 * i0), t1 = *(const f32x4*)(tabrow + 2 * i0 + 4);
    const float a0 = a[0] * t0[0] - a[1] * t0[1], a1 = a[1] * t0[0] + a[0] * t0[1];
    const float a2 = a[2] * t0[2] - a[3] * t0[3], a3 = a[3] * t0[2] + a[2] * t0[3];
    const float b0 = b[0] * t1[0] - b[1] * t1[1], b1 = b[1] * t1[0] + b[0] * t1[1];
    const float b2 = b[2] * t1[2] - b[3] * t1[3], b3 = b[3] * t1[2] + b[2] * t1[3];
    a = (f32x4){a0, a1, a2, a3}; b = (f32x4){b0, b1, b2, b3};
}
__device__ __forceinline__ float sq8(f32x4 a, f32x4 b) { return (a[0] * a[0] + a[1] * a[1]) + (a[2] * a[2] + a[3] * a[3]) + (b[0] * b[0] + b[1] * b[1]) + (b[2] * b[2] + b[3] * b[3]); }

struct EpiIn {
    bf16_t* Qa; bf16_t* KVa; bf16_t* CQ; bf16_t* CKV; bf16_t* KR; float* SSQ; float* SSKV; const float* rope;
    __device__ __forceinline__ void operator()(const Acc& acc, const Unit& u, int wr, int wc, int, int) const {
        const int lane_ = opaque_tid() & 63, fr = lane_ & 15, fq = lane_ >> 4;
        const int row0 = u.pm * BM + wr * 64 + fr, c8 = wc * 32 + 8 * fq;
#pragma unroll
        for (int ai = 0; ai < 2; ++ai)
#pragma unroll
            for (int m = 0; m < 4; ++m) {
                const int row = row0 + ai * HALF + m * 16; const float* tab = rope + (size_t)(row & (SEQ - 1)) * 64;
                if (u.pn < 4) {
#pragma unroll
                    for (int bj = 0; bj < 2; ++bj) { f32x4 a = acc[ai][bj][m][0], b = acc[ai][bj][m][1]; const int col = bj * HALF + c8;
                        rope8(a, b, tab, (col & 63) >> 1); a = a * C2SWA; b = b * C2SWA;
                        *(u32x4*)(Qa + (size_t)row * DM + u.pn * BM + col) = pack8(a, b); }
                } else if (u.pn == 4) {
                    { f32x4 a = acc[ai][0][m][0], b = acc[ai][0][m][1]; rope8(a, b, tab, (c8 & 63) >> 1); *(u32x4*)(KVa + (size_t)row * 256 + c8) = pack8(a, b); }
                    { *(u32x4*)(KVa + (size_t)row * 256 + HALF + c8) = pack8(acc[ai][1][m][0], acc[ai][1][m][1]); }
                } else if (u.pn == 5) {
                    float s = 0.f;
#pragma unroll
                    for (int bj = 0; bj < 2; ++bj) { const f32x4 a = acc[ai][bj][m][0], b = acc[ai][bj][m][1]; s += sq8(a, b);
                        *(u32x4*)(CQ + (size_t)row * 256 + bj * HALF + c8) = pack8(a, b); }
                    s += __shfl_xor(s, 16); s += __shfl_xor(s, 32);
                    if (fq == 0) SSQ[(size_t)row * 4 + wc] = s;
                } else {
                    { const f32x4 a = acc[ai][0][m][0], b = acc[ai][0][m][1]; float s = sq8(a, b);
                      *(u32x4*)(CKV + (size_t)row * 128 + c8) = pack8(a, b);
                      s += __shfl_xor(s, 16); s += __shfl_xor(s, 32);
                      if (fq == 0) SSKV[(size_t)row * 4 + wc] = s; }
                    if (wc < 2) { f32x4 a = acc[ai][1][m][0], b = acc[ai][1][m][1]; rope8(a, b, tab, c8 >> 1); *(u32x4*)(KR + (size_t)row * 64 + c8) = pack8(a, b); }
                }
            }
    }
};
struct EpiRows {
    bf16_t* O; int ldc; const float* SS; float inv_n; float mul; int rope_pn0; const float* rope;
    __device__ __forceinline__ void operator()(const Acc& acc, const Unit& u, int wr, int wc, int, int) const {
        const int lane_ = opaque_tid() & 63, fr = lane_ & 15, fq = lane_ >> 4;
        const int row0 = u.pm * BM + wr * 64 + fr, c8 = wc * 32 + 8 * fq;
#pragma unroll
        for (int ai = 0; ai < 2; ++ai)
#pragma unroll
            for (int m = 0; m < 4; ++m) {
                const int row = row0 + ai * HALF + m * 16;
                float r = mul;
                if (SS) { const f32x4 s4 = *(const f32x4*)(SS + (size_t)row * 4); r = mul * __builtin_amdgcn_rsqf(((s4[0] + s4[1]) + (s4[2] + s4[3])) * inv_n + EPS); }
#pragma unroll
                for (int bj = 0; bj < 2; ++bj) { f32x4 a = acc[ai][bj][m][0] * r, b = acc[ai][bj][m][1] * r; const int col = bj * HALF + c8;
                    if (u.pn >= rope_pn0) rope8(a, b, rope + (size_t)(row & (SEQ - 1)) * 64, (col & 63) >> 1);
                    *(u32x4*)(O + (size_t)row * ldc + u.pn * BM + col) = pack8(a, b); }
            }
    }
};
struct EpiGate {
    const bf16_t* OA; const bf16_t* OB; int ldb; bf16_t* MG;
    __device__ __forceinline__ void operator()(const Acc& acc, const Unit& u, int wr, int wc, int, int) const {
        const int lane_ = opaque_tid() & 63, fr = lane_ & 15, fq = lane_ >> 4;
        const int row0 = u.pm * BM + wr * 64 + fr, col = u.pn * HALF + wc * 32 + 8 * fq;
#pragma unroll
        for (int ai = 0; ai < 2; ++ai)
#pragma unroll
            for (int m = 0; m < 4; ++m) {
                const int row = row0 + ai * HALF + m * 16;
                const u32x4 oa = *(const u32x4*)(OA + (size_t)row * DM + col), ob = *(const u32x4*)(OB + (size_t)row * ldb + col);
                f32x4 r0, r1;
#pragma unroll
                for (int j = 0; j < 4; ++j) {
                    const float ga = fsigmoid(acc[ai][0][m][j >> 1][(j & 1) * 2]), ga1 = fsigmoid(acc[ai][0][m][j >> 1][(j & 1) * 2 + 1]);
                    const float gb = fsigmoid(acc[ai][1][m][j >> 1][(j & 1) * 2]), gb1 = fsigmoid(acc[ai][1][m][j >> 1][(j & 1) * 2 + 1]);
                    const float v0 = ga * bf_lo(oa[j]) + gb * bf_lo(ob[j]), v1 = ga1 * bf_hi(oa[j]) + gb1 * bf_hi(ob[j]);
                    if (j < 2) { r0[2 * j] = v0; r0[2 * j + 1] = v1; } else { r1[2 * (j - 2)] = v0; r1[2 * (j - 2) + 1] = v1; }
                }
                *(u32x4*)(MG + (size_t)row * DM + col) = pack8(r0, r1);
            }
    }
};
struct EpiRes {
    const float* X; float* H; bf16_t* HB;
    __device__ __forceinline__ void operator()(const Acc& acc, const Unit& u, int wr, int wc, int, int) const {
        const int lane_ = opaque_tid() & 63, fr = lane_ & 15, fq = lane_ >> 4;
        const int row0 = u.pm * BM + wr * 64 + fr, c8 = wc * 32 + 8 * fq;
#pragma unroll
        for (int ai = 0; ai < 2; ++ai)
#pragma unroll
            for (int m = 0; m < 4; ++m) {
                const int row = row0 + ai * HALF + m * 16;
#pragma unroll
                for (int bj = 0; bj < 2; ++bj) { const size_t off = (size_t)row * DM + u.pn * BM + bj * HALF + c8;
                    const f32x4 a = *(const f32x4*)(X + off) + acc[ai][bj][m][0], b = *(const f32x4*)(X + off + 4) + acc[ai][bj][m][1];
                    *(f32x4*)(H + off) = a; *(f32x4*)(H + off + 4) = b; *(u32x4*)(HB + off) = pack8(a, b); }
            }
    }
};
struct EpiMoeIn {
    const float* RG; const float* CW; bf16_t* ACT;
    __device__ __forceinline__ void operator()(const Acc& acc, const Unit& u, int wr, int wc, int, int) const {
        const int lane_ = opaque_tid() & 63, fr = lane_ & 15, fq = lane_ >> 4;
        const int row0 = u.pm * BM + wr * 64 + fr, col = u.pn * HALF + wc * 32 + 8 * fq;
#pragma unroll
        for (int ai = 0; ai < 2; ++ai)
#pragma unroll
            for (int m = 0; m < 4; ++m) {
                const int row = row0 + ai * HALF + m * 16; const float r = RG[row], cw = CW[row];
                f32x4 o[2];
#pragma unroll
                for (int n = 0; n < 2; ++n)
#pragma unroll
                    for (int j = 0; j < 4; ++j) { const float gt = r * acc[ai][0][m][n][j], up = r * acc[ai][1][m][n][j]; o[n][j] = gt * fsigmoid(gt) * up * cw; }
                *(u32x4*)(ACT + (size_t)row * DEXP + col) = pack8(o[0], o[1]);
            }
    }
};
struct EpiPle {
    float* H; const bf16_t* PP; const float* SS2;
    __device__ __forceinline__ void operator()(const Acc& acc, const Unit& u, int wr, int wc, int, int) const {
        const int lane_ = opaque_tid() & 63, fr = lane_ & 15, fq = lane_ >> 4;
        const int row0 = u.pm * BM + wr * 64 + fr, c8 = wc * 32 + 8 * fq;
#pragma unroll
        for (int ai = 0; ai < 2; ++ai)
#pragma unroll
            for (int m = 0; m < 4; ++m) {
                const int row = row0 + ai * HALF + m * 16; const float r = __builtin_amdgcn_rsqf(SS2[row] * (1.f / DM) + EPS);
#pragma unroll
                for (int bj = 0; bj < 2; ++bj) { const size_t off = (size_t)row * DM + u.pn * BM + bj * HALF + c8;
                    const u32x4 pp = *(const u32x4*)(PP + off); f32x4 a = *(const f32x4*)(H + off), b = *(const f32x4*)(H + off + 4);
                    const f32x4 g0 = acc[ai][bj][m][0] * r, g1 = acc[ai][bj][m][1] * r;
                    a[0] += fsigmoid(g0[0]) * bf_lo(pp[0]); a[1] += fsigmoid(g0[1]) * bf_hi(pp[0]); a[2] += fsigmoid(g0[2]) * bf_lo(pp[1]); a[3] += fsigmoid(g0[3]) * bf_hi(pp[1]);
                    b[0] += fsigmoid(g1[0]) * bf_lo(pp[2]); b[1] += fsigmoid(g1[1]) * bf_hi(pp[2]); b[2] += fsigmoid(g1[2]) * bf_lo(pp[3]); b[3] += fsigmoid(g1[3]) * bf_hi(pp[3]);
                    *(f32x4*)(H + off) = a; *(f32x4*)(H + off + 4) = b; }
            }
    }
};
}

namespace att {
__device__ __forceinline__ int v_st(int k, int c) { const int kk = (k & ~0xC) | ((k & 4) << 1) | ((k & 8) >> 1); return ((kk >> 3) * 4 + (c >> 5)) * 512 + ((kk & 7) * 32 + (c & 31)) * 2; }
__device__ __forceinline__ int v_rd_base(int lane) { return ((lane & 3) << 3) | (((lane >> 2) & 3) << 6) | (((lane >> 4) & 1) << 5) | (((lane >> 5) & 1) << 8); }
__device__ __forceinline__ int crow(int r, int hi) { return (r & 3) + 8 * (r >> 2) + 4 * hi; }
typedef short v4i16_t __attribute__((ext_vector_type(4)));
__device__ __forceinline__ s16x4 vtr(const LAS char* p) { return __builtin_bit_cast(s16x4, __builtin_amdgcn_ds_read_tr16_b64_v4i16((LAS v4i16_t*)p)); }
__device__ __forceinline__ void mask_tile(f32x16& p0, f32x16& p1, int dq, unsigned W) {
    const float NEG = -__builtin_inff();
#pragma unroll
    for (int r = 0; r < 16; ++r) {
        const int c = (r & 3) + 8 * (r >> 2);
        if ((unsigned)(dq - c) >= W) p0[r] = NEG;
        if ((unsigned)(dq - c - 32) >= W) p1[r] = NEG;
    }
}
constexpr float THR = 10.f;
template <int DQK, int DV> struct Geo { static constexpr int KROW = DQK * 2 + 16, KBUF = 64 * KROW, VBUF = 16384, LDS_V = 2 * KBUF, LDS_S = LDS_V + 2 * VBUF, LDS_BYTES = LDS_S + 8 * 256; };

template <int DQK, int DV, int K1W>
__device__ __forceinline__ void attn_unit(LAS char* lds, const bf16_t* q1, const bf16_t* q2, int QP,
                                          const bf16_t* K1, int K1P, const bf16_t* K2, int K2P, const bf16_t* Vp, int VP,
                                          int j_lo, int j_hi, int qlo, unsigned W, float m0, float l0, bf16_t* ow, int OP) {
    typedef Geo<DQK, DV> G;
    constexpr int NQF = DQK / 16, ND0 = DV / 32, K1C = K1W / 8, K2C = (DQK - K1W) / 8, VC = DV / 8;
    constexpr int NK1 = (64 * K1C) / 512, NK2 = (64 * K2C + 511) / 512, NV = (64 * VC) / 512;
    static_assert(NK1 >= 1 && NK1 <= 2 && NK2 <= 1 && NV >= 1 && NV <= 2, "staging geometry");
    const int tid = opaque_tid(), lane = tid & 63, r32 = lane & 31, hi = lane >> 5; const int wid = __builtin_amdgcn_readfirstlane(tid >> 6);
    LAS float* wsf = (LAS float*)(lds + G::LDS_S) + wid * 64;
    bf16x8 qr[NQF];
#pragma unroll
    for (int d0 = 0; d0 < NQF; ++d0) {
        if (d0 * 16 < K1W) qr[d0] = *(const bf16x8*)(q1 + (size_t)r32 * QP + d0 * 16 + hi * 8);
        else qr[d0] = *(const bf16x8*)(q2 + (size_t)r32 * QP + (d0 * 16 - K1W) + hi * 8);
    }
    const int k1r = tid / K1C, k1c = tid % K1C;
    const int k2r = K2C ? tid / (K2C ? K2C : 1) : 0, k2c = K2C ? tid % (K2C ? K2C : 1) : 0;
    const int vr = tid / VC, vc = tid % VC;
    bf16x8 sk1[NK1], sk2[NK2 ? NK2 : 1], sv[NV];
#define ATT_LOAD(kb) do { \
        _Pragma("unroll") for (int i = 0; i < NK1; ++i) sk1[i] = *(const bf16x8*)(K1 + (size_t)((kb) + k1r + i * (512 / K1C)) * K1P + k1c * 8); \
        if (NK2) sk2[0] = *(const bf16x8*)(K2 + (size_t)((kb) + k2r) * K2P + k2c * 8); \
        _Pragma("unroll") for (int i = 0; i < NV; ++i) sv[i] = *(const bf16x8*)(Vp + (size_t)((kb) + vr + i * (512 / VC)) * VP + vc * 8); } while (0)
#define ATT_WRITE(buf) do { \
        _Pragma("unroll") for (int i = 0; i < NK1; ++i) *(LAS bf16x8*)(lds + (buf) * G::KBUF + (k1r + i * (512 / K1C)) * G::KROW + k1c * 16) = sk1[i]; \
        if (NK2) *(LAS bf16x8*)(lds + (buf) * G::KBUF + k2r * G::KROW + (K1C + k2c) * 16) = sk2[0]; \
        _Pragma("unroll") for (int i = 0; i < NV; ++i) *(LAS bf16x8*)(lds + G::LDS_V + (buf) * G::VBUF + v_st(vr + i * (512 / VC), vc * 8)) = sv[i]; } while (0)
    float m_reg = m0, l_reg = l0;
    f32x16 o[ND0];
#pragma unroll
    for (int d = 0; d < ND0; ++d) o[d] = f32x16{};
    const int qm = qlo + r32 - 4 * hi;
    const int NT = j_hi - j_lo;
    ATT_LOAD(j_lo * 64);
    ATT_WRITE(0);
    __syncthreads();
    const LAS char* kp0 = lds + r32 * G::KROW + hi * 16;
    const LAS char* vp0 = lds + G::LDS_V + v_rd_base(lane);
    for (int t = 0; t < NT; ++t) {
        const int buf = t & 1, kb = (j_lo + t) * 64;
        if (t + 1 < NT) ATT_LOAD(kb + 64);
        f32x16 p0 = f32x16{}, p1 = f32x16{};
        { const LAS char* kp = kp0 + buf * G::KBUF;
#pragma unroll
          for (int d0 = 0; d0 < NQF; ++d0) {
              const bf16x8 b0 = *(const LAS bf16x8*)(kp + d0 * 32), b1 = *(const LAS bf16x8*)(kp + 32 * G::KROW + d0 * 32);
              p0 = __builtin_amdgcn_mfma_f32_32x32x16_bf16(b0, qr[d0], p0, 0, 0, 0);
              p1 = __builtin_amdgcn_mfma_f32_32x32x16_bf16(b1, qr[d0], p1, 0, 0, 0); } }
        if (kb + 63 > qlo || (long)kb <= (long)qlo + 31 - (long)W) mask_tile(p0, p1, qm - kb, W);
        float pmax = p0[0];
#pragma unroll
        for (int r = 1; r < 16; ++r) pmax = fmaxf(pmax, p0[r]);
#pragma unroll
        for (int r = 0; r < 16; ++r) pmax = fmaxf(pmax, p1[r]);
        { auto rr = __builtin_amdgcn_permlane32_swap(__float_as_uint(pmax), __float_as_uint(pmax), false, false);
          pmax = fmaxf(__uint_as_float(rr[0]), __uint_as_float(rr[1])); }
        float alpha = 1.f;
        if (!__all(pmax - m_reg <= THR)) {
            const float mn = fmaxf(m_reg, pmax); alpha = __builtin_amdgcn_exp2f(m_reg - mn); m_reg = mn;
            if (hi == 0) wsf[r32] = alpha;
#pragma unroll
            for (int d = 0; d < ND0; ++d)
#pragma unroll
                for (int r = 0; r < 16; ++r) o[d][r] *= wsf[crow(r, hi)];
        }
        float ps = 0.f;
#pragma unroll
        for (int r = 0; r < 16; ++r) { p0[r] = __builtin_amdgcn_exp2f(p0[r] - m_reg); ps += p0[r]; }
#pragma unroll
        for (int r = 0; r < 16; ++r) { p1[r] = __builtin_amdgcn_exp2f(p1[r] - m_reg); ps += p1[r]; }
        { auto rr = __builtin_amdgcn_permlane32_swap(__float_as_uint(ps), __float_as_uint(ps), false, false);
          ps = __uint_as_float(rr[0]) + __uint_as_float(rr[1]); }
        l_reg = l_reg * alpha + ps;
        bf16x8 pa0, pa1, pa2, pa3;
#define PK4(P, B_, OUT) do { unsigned a0 = cvt_pk_bf16(P[B_+0], P[B_+1]), a1 = cvt_pk_bf16(P[B_+2], P[B_+3]); \
        unsigned b0_ = cvt_pk_bf16(P[B_+4], P[B_+5]), b1_ = cvt_pk_bf16(P[B_+6], P[B_+7]); \
        auto r0 = __builtin_amdgcn_permlane32_swap(a0, b0_, false, false); auto r1 = __builtin_amdgcn_permlane32_swap(a1, b1_, false, false); \
        u32x4 w = {r0[0], r1[0], r0[1], r1[1]}; OUT = __builtin_bit_cast(bf16x8, w); } while (0)
        PK4(p0, 0, pa0); PK4(p0, 8, pa1); PK4(p1, 0, pa2); PK4(p1, 8, pa3);
#undef PK4
        { const LAS char* vp = vp0 + buf * G::VBUF;
#pragma unroll
          for (int d0 = 0; d0 < ND0; ++d0) {
              s16x4 l_[4], h_[4];
#pragma unroll
              for (int ks = 0; ks < 4; ++ks) { l_[ks] = vtr(vp + d0 * 512 + ks * 4096); h_[ks] = vtr(vp + d0 * 512 + ks * 4096 + 2048); }
#define VF(k) (bf16x8){l_[k][0], l_[k][1], l_[k][2], l_[k][3], h_[k][0], h_[k][1], h_[k][2], h_[k][3]}
              o[d0] = __builtin_amdgcn_mfma_f32_32x32x16_bf16(pa0, VF(0), o[d0], 0, 0, 0);
              o[d0] = __builtin_amdgcn_mfma_f32_32x32x16_bf16(pa1, VF(1), o[d0], 0, 0, 0);
              o[d0] = __builtin_amdgcn_mfma_f32_32x32x16_bf16(pa2, VF(2), o[d0], 0, 0, 0);
              o[d0] = __builtin_amdgcn_mfma_f32_32x32x16_bf16(pa3, VF(3), o[d0], 0, 0, 0);
#undef VF
          } }
        if (t + 1 < NT) ATT_WRITE(buf ^ 1);
        __syncthreads();
    }
#undef ATT_LOAD
#undef ATT_WRITE
    if (hi == 0) wsf[32 + r32] = l_reg;
    float rli[16];
#pragma unroll
    for (int r = 0; r < 16; ++r) rli[r] = __builtin_amdgcn_rcpf(wsf[32 + crow(r, hi)]);
#pragma unroll
    for (int r = 0; r < 16; ++r) { const int orow = crow(r, hi);
#pragma unroll
        for (int d0 = 0; d0 < ND0; ++d0) { const float v = o[d0][r] * rli[r]; const float vn = __shfl_xor(v, 1);
            if ((r32 & 1) == 0) *(unsigned*)(ow + (size_t)orow * OP + d0 * 32 + r32) = cvt_pk_bf16(v, vn); } }
}
}

constexpr int NWAVES = 8;
constexpr size_t MiB = 1u << 20, KiB = 1u << 10;
constexpr size_t WS_CTL = 0, CTL_ZERO_BYTES = 64 * KiB;
constexpr size_t WS_META = 64 * KiB;
constexpr size_t WS_SSQ = 1 * MiB, WS_SSKV = WS_SSQ + 256 * KiB, WS_SS2 = WS_SSKV + 256 * KiB;
constexpr size_t WS_TOKE = WS_SS2 + 64 * KiB, WS_TOKPOS = WS_TOKE + 64 * KiB, WS_TOKCW = WS_TOKPOS + 128 * KiB, WS_TOKR = WS_TOKCW + 128 * KiB, WS_TOKSLOT = WS_TOKR + 64 * KiB;
constexpr size_t WS_RG = WS_TOKSLOT + 128 * KiB, WS_CWS = WS_RG + 256 * KiB, WS_WR = WS_CWS + 256 * KiB;
static_assert(WS_WR + 80 * KiB <= 4 * MiB, "small arrays");
constexpr size_t WS_ROPE = 4 * MiB;
constexpr size_t WS_WIN = 8 * MiB, WS_WG = 12 * MiB, WS_WUQ = 16 * MiB, WS_WUKV = 17 * MiB, WS_WOUT = 18 * MiB, WS_WEI = 20 * MiB, WS_WEO = 36 * MiB, WS_WPG = 44 * MiB, WS_WPP = 46 * MiB;
constexpr size_t WS_XN = 48 * MiB, WS_PB = 80 * MiB, WS_PP = 88 * MiB, WS_QA = 120 * MiB, WS_KVA = 152 * MiB, WS_CQ = 160 * MiB, WS_CKV = 168 * MiB, WS_KR = 172 * MiB,
                 WS_Q = 174 * MiB, WS_MG = 222 * MiB, WS_XG = 120 * MiB, WS_ACT = 192 * MiB, WS_Y = 120 * MiB, WS_HB = 48 * MiB, WS_END = 256 * MiB;
static_assert(WS_Q + (size_t)T_TOK * QW * 2 <= WS_MG && WS_MG + (size_t)T_TOK * DM * 2 <= WS_END && WS_XG + (size_t)MAXSLOTS * DM * 2 <= WS_ACT && WS_ACT + (size_t)MAXSLOTS * DEXP * 2 <= WS_MG, "d_ws map");
constexpr int CW_BAR = 1024, CW_CNT = 8192;
constexpr int RING_BYTES = 131072, LDSCTL_OFF = RING_BYTES, MISC_OFF = LDSCTL_OFF + 320, LDS_BYTES = 147456;

typedef GAS unsigned gu32;
#define RLX_AGENT __ATOMIC_RELAXED, __HIP_MEMORY_SCOPE_AGENT
#define LDS_WAIT() asm volatile("s_waitcnt lgkmcnt(0)" ::: "memory")

#define XB_TMO      128
#define XB_XCNT(j)  (256  + 64 * (j))
#define XB_XSUB(j)  (1280 + 64 * (j))
#define XB_XGEN(j)  (2304 + 64 * (j))
#define XB_TOP      3328
#define XB_TOPGEN   3392
#define XCD_BAR_WORDS 3456
#define XB_SPIN_CAP (1u << 18)
__device__ __forceinline__ unsigned xb_ld(unsigned* p)              { return __hip_atomic_load(p, __ATOMIC_RELAXED, __HIP_MEMORY_SCOPE_AGENT); }
__device__ __forceinline__ unsigned xb_add(unsigned* p, unsigned v) { return __hip_atomic_fetch_add(p, v, __ATOMIC_RELAXED, __HIP_MEMORY_SCOPE_AGENT); }
__device__ __forceinline__ unsigned xb_xcc_id() { return (unsigned)__builtin_amdgcn_s_getreg((3 << 11) | 20) & 0xFu; }
#define XB_SPIN(cond, bar) do { unsigned _sp = 0; while (cond) { __builtin_amdgcn_s_sleep(1); \
    if ((++_sp & 255u) == 0u) { if (xb_ld(&(bar)[XB_TMO])) break; if (_sp > XB_SPIN_CAP) { atomicAdd(&(bar)[XB_TMO], 1u); break; } } } } while (0)
struct XcdBarrier { unsigned* bar; unsigned x; volatile LAS unsigned* st; };
__device__ __forceinline__ XcdBarrier xcd_barrier_post(unsigned* bar, volatile LAS unsigned* st) {
    XcdBarrier b; b.bar = bar; b.x = xb_xcc_id(); b.st = st;
    if (threadIdx.x == 0) (void)xb_add(&bar[XB_XCNT(b.x)], 1u);
    return b;
}
__device__ __forceinline__ void xcd_barrier_complete(unsigned* bar, unsigned x, unsigned& nloc, unsigned& nx) {
    const unsigned G = gridDim.x * gridDim.y * gridDim.z;
    unsigned sum, cnt, mine, sp = 0u;
    for (;;) {
        sum = 0u; cnt = 0u; mine = 0u;
#pragma unroll
        for (unsigned j = 0; j < 16; ++j) { const unsigned c = xb_ld(&bar[XB_XCNT(j)]); sum += c; cnt += (c > 0u) ? 1u : 0u; mine = (j == x) ? c : mine; }
        if (sum == G) break;
        __builtin_amdgcn_s_sleep(1);
        if ((++sp & 255u) == 0u) { if (xb_ld(&bar[XB_TMO])) break; if (sp > XB_SPIN_CAP) { atomicAdd(&bar[XB_TMO], 1u); break; } }
    }
    nloc = mine > 0u ? mine : 1u; nx = cnt > 0u ? cnt : 1u;
}
__device__ __forceinline__ void xcd_barrier(const XcdBarrier& b) {
    asm volatile("s_waitcnt vmcnt(0)" ::: "memory");
    __syncthreads();
    if (threadIdx.x == 0) {
        unsigned* bar = b.bar;
        __builtin_amdgcn_s_waitcnt(0);
        unsigned nloc = b.st[0], nx = b.st[1];
        if (nloc == 0u) { xcd_barrier_complete(bar, b.x, nloc, nx); b.st[0] = nloc; b.st[1] = nx; }
        const unsigned old = xb_add(&bar[XB_XSUB(b.x)], 1u);
        const unsigned gen = old / nloc;
        if (old + 1u == (gen + 1u) * nloc) {
            __builtin_amdgcn_fence(__ATOMIC_RELEASE, "agent");
            asm volatile("s_waitcnt vmcnt(0)" ::: "memory");
            const unsigned og = xb_add(&bar[XB_TOP], 1u);
            const unsigned tg = og / nx;
            if (og + 1u == (tg + 1u) * nx) xb_add(&bar[XB_TOPGEN], 1u);
            else XB_SPIN(xb_ld(&bar[XB_TOPGEN]) == tg, bar);
            __builtin_amdgcn_fence(__ATOMIC_ACQUIRE, "agent");
            xb_add(&bar[XB_XGEN(b.x)], 1u);
            asm volatile("s_waitcnt vmcnt(0)" ::: "memory");
        } else {
            XB_SPIN(xb_ld(&bar[XB_XGEN(b.x)]) == gen, bar);
            __builtin_amdgcn_fence(__ATOMIC_ACQUIRE, "agent");
            asm volatile("s_waitcnt vmcnt(0)" ::: "memory");
        }
    }
    __syncthreads();
}

__device__ __forceinline__ int pairperm(int j) { return ((j & 1) ? 32 : 0) + (j >> 1); }
__device__ __forceinline__ int src_col(int mat, int n) {
    switch (mat) {
    case 0: if (n < 1152) return (n & ~63) + pairperm(n & 63); if (n < 1664) return n; if (n < 1728) return 1664 + pairperm(n - 1664); return -1;
    case 1: { const int t = n >> 8, j = n & 255; return j < 128 ? 1728 + 128 * t + j : 2752 + 128 * t + (j - 128); }
    case 2: if (n < 1024) return (n >> 7) * 192 + (n & 127); else { const int m = n - 1024; return (m >> 6) * 192 + 128 + pairperm(m & 63); }
    case 4: { const int pn = n >> 8, j = n & 255; return j < 128 ? 128 * pn + j : 256 + 128 * pn + (j - 128); }
    default: return n;
    }
}
__device__ __forceinline__ void transpose_item(const float* W, int ldw, int K, int N, const float* gain, int mat, bf16_t* WT, LAS float* scr, int item, int lane) {
    const int nblk = N / 32, kb = item / nblk, nb = item % nblk, k0 = 64 * kb, n0 = 32 * nb;
    int sc = src_col(mat, n0 + (lane & 31)); const float msk = sc >= 0 ? 1.f : 0.f; sc = sc >= 0 ? sc : 0;
#pragma unroll 8
    for (int i = 0; i < 32; ++i) { const int kk = 2 * i + (lane >> 5); float v = W[(size_t)(k0 + kk) * ldw + sc] * msk; if (gain) v *= gain[k0 + kk]; scr[kk * 33 + (lane & 31)] = v; }
    LDS_WAIT(); asm volatile("" ::: "memory");
    const int c = lane & 7;
#pragma unroll
    for (int j = 0; j < 4; ++j) { const int n = (lane >> 3) + 8 * j; const LAS float* s = scr + (8 * c) * 33 + n;
        u32x4 o; o.x = cvt_pk_bf16(s[0 * 33], s[1 * 33]); o.y = cvt_pk_bf16(s[2 * 33], s[3 * 33]); o.z = cvt_pk_bf16(s[4 * 33], s[5 * 33]); o.w = cvt_pk_bf16(s[6 * 33], s[7 * 33]);
        *(u32x4*)(WT + (size_t)(n0 + n) * K + k0 + 8 * c) = o; }
    LDS_WAIT(); asm volatile("" ::: "memory");
}
__device__ __forceinline__ void sincos_d(float ang, float& c, float& s) {
    const double x = (double)ang, q = __builtin_rint(x * 0.63661977236758134308);
    double r = __builtin_fma(-q, 1.5707963267948966, x); r = __builtin_fma(-q, 6.123233995736766e-17, r);
    const double r2 = r * r;
    double sp = -1.0 / 1307674368000.0; sp = sp * r2 + 1.0 / 6227020800.0; sp = sp * r2 - 1.0 / 39916800.0; sp = sp * r2 + 1.0 / 362880.0; sp = sp * r2 - 1.0 / 5040.0; sp = sp * r2 + 1.0 / 120.0; sp = sp * r2 - 1.0 / 6.0; sp = sp * r2 + 1.0;
    const double sr = sp * r;
    double cp = 1.0 / 20922789888000.0; cp = cp * r2 - 1.0 / 87178291200.0; cp = cp * r2 + 1.0 / 479001600.0; cp = cp * r2 - 1.0 / 3628800.0; cp = cp * r2 + 1.0 / 40320.0; cp = cp * r2 - 1.0 / 720.0; cp = cp * r2 + 1.0 / 24.0; cp = cp * r2 - 0.5; cp = cp * r2 + 1.0;
    const int n = ((int)q) & 3;
    const double cc = (n == 0) ? cp : (n == 1) ? -sr : (n == 2) ? -cp : sr;
    const double ss = (n == 0) ? sr : (n == 1) ? cp : (n == 2) ? -sr : -cp;
    c = (float)cc; s = (float)ss;
}

typedef const __attribute__((address_space(4))) char* kptr_t;
__device__ __forceinline__ kptr_t kargp() { kptr_t p = (kptr_t)__builtin_amdgcn_kernarg_segment_ptr(); asm volatile("" : "+s"(p)); return p; }
template <class T> __device__ __forceinline__ T karg(kptr_t kp, int off) { return *(const __attribute__((address_space(4))) T*)(kp + off); }
#define KP_INIT kptr_t kp_ = kargp(); unsigned char* ws = karg<unsigned char*>(kp_, 176); (void)ws;
#define INP(i) karg<const float*>(kp_, 8 * (i))
#define OUTP karg<float*>(kp_, 168)
#define WSP(T, off) ((T*)(ws + (off)))
struct Args { const float* in[21]; float* out; unsigned char* ws; int ph_lo, ph_hi; };
constexpr int NPHASE = 13;

__global__ void __launch_bounds__(NWAVES * 64, 2) mk_fwd(Args) {
    extern __shared__ __attribute__((aligned(16))) unsigned char lds_raw[];
    LAS unsigned char* lds = (LAS unsigned char*)lds_raw;
    volatile LAS unsigned* MISC = (volatile LAS unsigned*)(lds + MISC_OFF);
    const int G = gridDim.x, bx = blockIdx.x, vcu = (G % 8 == 0) ? (bx % 8) * (G / 8) + bx / 8 : bx;
    const int NGW = G * NWAVES;
#define PH_IDS const int tid = opaque_tid(), lane = tid & 63, wave = __builtin_amdgcn_readfirstlane(tid >> 6), gw = vcu * NWAVES + wave; (void)lane; (void)gw;
    gu32* ctl; { KP_INIT ctl = (gu32*)(ws + WS_CTL); }
    { PH_IDS for (int u = tid; u < (LDS_BYTES - LDSCTL_OFF) / 4; u += NWAVES * 64) ((LAS unsigned*)(lds + LDSCTL_OFF))[u] = 0u; }
    __syncthreads();
    XcdBarrier bar; bar.bar = (unsigned*)(ctl + CW_BAR); bar.x = 0; bar.st = nullptr;
#if MK_ONE_LAUNCH
    bar = xcd_barrier_post((unsigned*)(ctl + CW_BAR), MISC + 8);
#define GRID_BAR() xcd_barrier(bar)
#else
#define GRID_BAR() do {} while (0)
#endif
    int lo, hi_ph; { KP_INIT lo = karg<int>(kp_, 184); hi_ph = karg<int>(kp_, 188); }
#ifndef PH_MASK
#define PH_MASK 0x1fff
#endif
#define IN(k) ((((PH_MASK) >> (k)) & 1) && lo <= (k) && (k) < hi_ph)
#define SEAM(k) do { if (IN(k) && IN((k) + 1)) GRID_BAR(); } while (0)

    if (IN(0)) { PH_IDS
        KP_INIT const float* x = INP(0); const float* p_in = INP(1); const float* g_mix = INP(2); const float* w_in = INP(3); const float* g_q = INP(5); const float* w_uq = INP(6); const float* g_kv = INP(7); const float* w_ukv = INP(8); const float* w_out = INP(9);
        const float* g_ffn = INP(10); const float* w_rg = INP(11); const float* w_re = INP(13); const float* w_ei = INP(15); const float* w_eo = INP(16); const float* g_ple = INP(17); const float* w_pg = INP(18); const float* w_pp = INP(19);
        bf16_t* Win_t = WSP(bf16_t, WS_WIN); bf16_t* Wg_t = WSP(bf16_t, WS_WG); bf16_t* Wuq_t = WSP(bf16_t, WS_WUQ); bf16_t* Wukv_t = WSP(bf16_t, WS_WUKV); bf16_t* Wout_t = WSP(bf16_t, WS_WOUT); bf16_t* Wei_t = WSP(bf16_t, WS_WEI);
        bf16_t* Weo_t = WSP(bf16_t, WS_WEO); bf16_t* Wpg_t = WSP(bf16_t, WS_WPG); bf16_t* Wpp_t = WSP(bf16_t, WS_WPP); bf16_t* XN = WSP(bf16_t, WS_XN); bf16_t* PB = WSP(bf16_t, WS_PB); float* WR = WSP(float, WS_WR); float* ROPE = WSP(float, WS_ROPE);
        LAS float* scr = (LAS float*)(lds + wave * 16384);
        constexpr int I_IN = 16 * (N1 / 32), I_G = 16 * (NGATE / 32), I_UQ = 4 * (QW / 32), I_UKV = 2 * (KVW / 32), I_OUT = 16 * 32, I_EI1 = 16 * 16, I_EI = NEXP * I_EI1,
                      I_EO1 = 4 * 32, I_EO = NEXP * I_EO1, I_PG = 16 * 32, I_PP = 4 * 32;
        constexpr int NITEMS = I_IN + I_G + I_UQ + I_UKV + I_OUT + I_EI + I_EO + I_PG + I_PP;
        for (int it = gw; it < NITEMS; it += NGW) {
            int r = it;
            if (r < I_IN) { transpose_item(w_in, 3776, 1024, N1, nullptr, 0, Win_t, scr, r, lane); continue; } r -= I_IN;
            if (r < I_G) { transpose_item(w_in, 3776, 1024, NGATE, nullptr, 1, Wg_t, scr, r, lane); continue; } r -= I_G;
            if (r < I_UQ) { transpose_item(w_uq, QW, 256, QW, g_q, 2, Wuq_t, scr, r, lane); continue; } r -= I_UQ;
            if (r < I_UKV) { transpose_item(w_ukv, KVW, 128, KVW, g_kv, 3, Wukv_t, scr, r, lane); continue; } r -= I_UKV;
            if (r < I_OUT) { transpose_item(w_out, 1024, 1024, 1024, nullptr, 3, Wout_t, scr, r, lane); continue; } r -= I_OUT;
            if (r < I_EI) { const int e = r / I_EI1; transpose_item(w_ei + (size_t)e * 1024 * 512, 512, 1024, 512, g_ffn, 4, Wei_t + (size_t)e * 512 * 1024, scr, r % I_EI1, lane); continue; } r -= I_EI;
            if (r < I_EO) { const int e = r / I_EO1; transpose_item(w_eo + (size_t)e * 256 * 1024, 1024, 256, 1024, nullptr, 3, Weo_t + (size_t)e * 1024 * 256, scr, r % I_EO1, lane); continue; } r -= I_EO;
            if (r < I_PG) { transpose_item(w_pg, 1024, 1024, 1024, g_ple, 3, Wpg_t, scr, r, lane); continue; } r -= I_PG;
            transpose_item(w_pp, 1024, 256, 1024, nullptr, 3, Wpp_t, scr, r, lane);
        }
        for (int m = gw; m < T_TOK; m += NGW) {
            const f32x4* xr = (const f32x4*)(x + (size_t)m * DM) + lane; f32x4 v[4]; float s = 0.f;
#pragma unroll
            for (int j = 0; j < 4; ++j) { v[j] = xr[64 * j]; s += (v[j].x * v[j].x + v[j].y * v[j].y) + (v[j].z * v[j].z + v[j].w * v[j].w); }
            const float rs = __builtin_amdgcn_rsqf(wave_sum(s) * (1.f / DM) + EPS);
            u32x2* o8 = (u32x2*)(XN + (size_t)m * DM) + lane;
#pragma unroll
            for (int j = 0; j < 4; ++j) { const f32x4 gg = *((const f32x4*)g_mix + lane + 64 * j); u32x2 w; w.x = cvt_pk_bf16(v[j].x * rs * gg.x, v[j].y * rs * gg.y); w.y = cvt_pk_bf16(v[j].z * rs * gg.z, v[j].w * rs * gg.w); o8[64 * j] = w; }
            const f32x4 pv = *((const f32x4*)(p_in + (size_t)m * 256) + lane); u32x2 w; w.x = cvt_pk_bf16(pv.x, pv.y); w.y = cvt_pk_bf16(pv.z, pv.w);
            *((u32x2*)(PB + (size_t)m * 256) + lane) = w;
        }
        for (int e = bx * (NWAVES * 64) + tid; e < SEQ * 32; e += G * NWAVES * 64) {
            const int pos = e >> 5, i = e & 31; const float inv = powf(10000.f, -(float)(2 * i) / 64.f); const float ang = (float)pos * inv;
            float c, s; sincos_d(ang, c, s); *(f32x2*)(ROPE + (size_t)e * 2) = (f32x2){c, s};
        }
        for (int e = bx * (NWAVES * 64) + tid; e < 20 * 1024; e += G * NWAVES * 64) {
            const int j = e >> 10, k = e & 1023; WR[e] = g_ffn[k] * (j < 4 ? w_rg[k * 4 + j] : w_re[k * 16 + (j - 4)]);
        }
    }
    SEAM(0);
    if (IN(1)) {
        KP_INIT bf16_t* XN = WSP(bf16_t, WS_XN); bf16_t* Win_t = WSP(bf16_t, WS_WIN); bf16_t* PB = WSP(bf16_t, WS_PB); bf16_t* Wpp_t = WSP(bf16_t, WS_WPP); bf16_t* PP = WSP(bf16_t, WS_PP); bf16_t* QA = WSP(bf16_t, WS_QA); bf16_t* KVA = WSP(bf16_t, WS_KVA);
        bf16_t* CQ = WSP(bf16_t, WS_CQ); bf16_t* CKV = WSP(bf16_t, WS_CKV); bf16_t* KR = WSP(bf16_t, WS_KR); float* SSQ = WSP(float, WS_SSQ); float* SSKV = WSP(float, WS_SSKV); float* ROPE = WSP(float, WS_ROPE);
        { pg8::Gemm g{XN, Win_t, 1024}; pg8::StaticOrder S; S.init(T_TOK, N1, G, bx);
          pg8::EpiIn E{QA, KVA, CQ, CKV, KR, SSQ, SSKV, ROPE}; pg8::gemm_phase(lds, g, S, E); }
        { pg8::Gemm g{PB, Wpp_t, 256}; pg8::StaticOrder S; S.init(T_TOK, 1024, G, (bx + 64) % G);
          pg8::EpiRows E{PP, DM, nullptr, 0.f, 1.f, 1 << 30, nullptr}; pg8::gemm_phase(lds, g, S, E); }
    }
    SEAM(1);
    if (IN(2)) { PH_IDS
        KP_INIT const float* sinks = INP(4); bf16_t* CQ = WSP(bf16_t, WS_CQ); bf16_t* CKV = WSP(bf16_t, WS_CKV); bf16_t* Wuq_t = WSP(bf16_t, WS_WUQ); bf16_t* Wukv_t = WSP(bf16_t, WS_WUKV); bf16_t* Qm = WSP(bf16_t, WS_Q); bf16_t* KVm = (bf16_t*)OUTP;
        bf16_t* QA = WSP(bf16_t, WS_QA); bf16_t* KVA = WSP(bf16_t, WS_KVA); float* SSQ = WSP(float, WS_SSQ); float* SSKV = WSP(float, WS_SSKV); float* ROPE = WSP(float, WS_ROPE);
        { pg8::Gemm g{CQ, Wuq_t, 256}; pg8::StaticOrder S; S.init(T_TOK, QW, G, bx);
          pg8::EpiRows E{Qm, QW, SSQ, 1.f / 256.f, C2MLA, 4, ROPE}; pg8::gemm_phase(lds, g, S, E); }
        { pg8::Gemm g{CKV, Wukv_t, 128}; pg8::StaticOrder S; S.init(T_TOK, KVW, G, bx);
          pg8::EpiRows E{KVm, KVW, SSKV, 1.f / 128.f, 1.f, 1 << 30, nullptr}; pg8::gemm_phase(lds, g, S, E); }
        for (int uidx = vcu; uidx < 2 * 2 * 256; uidx += G) {
            const int pblk = uidx & 255, kvh = (uidx >> 8) & 1, b = uidx >> 9;
            const int h = kvh * 8 + wave, pos0 = pblk * 32; const size_t rowb = (size_t)b * SEQ;
            const int lowk = pos0 - 127; const int j_lo = lowk > 0 ? lowk / 64 : 0, j_hi = (pos0 + 31) / 64 + 1;
            const bf16_t* qp = QA + (rowb + pos0) * DM + h * 64;
            att::attn_unit<64, 64, 64>((LAS char*)lds, qp, qp, DM, KVA + rowb * 256 + kvh * 64, 256, nullptr, 0, KVA + rowb * 256 + 128 + kvh * 64, 256,
                                       j_lo, j_hi, pos0, 128u, sinks[h] * LOG2E, 1.f, QA + (rowb + pos0) * DM + h * 64, DM);
        }
    }
    SEAM(2);
    if (IN(3)) { PH_IDS
        KP_INIT bf16_t* Qm = WSP(bf16_t, WS_Q); bf16_t* KVm = (bf16_t*)OUTP; bf16_t* KR = WSP(bf16_t, WS_KR);
        for (int pi = vcu; pi < 256; pi += G) {
            const int bh = pi >> 4, s = pi & 15, b = bh >> 3, h = bh & 7; const size_t rowb = (size_t)b * SEQ;
            for (int pass = 0; pass < 2; ++pass) {
                const int qb = pass == 0 ? 31 - s : s, q0 = qb * 256 + wave * 32;
                const bf16_t* q1 = Qm + (rowb + q0) * QW + h * 128; const bf16_t* q2 = Qm + (rowb + q0) * QW + 1024 + h * 64;
                att::attn_unit<192, 128, 128>((LAS char*)lds, q1, q2, QW, KVm + rowb * KVW + h * 256, KVW, KR + rowb * 64, 64, KVm + rowb * KVW + h * 256 + 128, KVW,
                                              0, (qb + 1) * 4, q0, 1u << 30, -1e30f, 0.f, Qm + (rowb + q0) * QW + h * 128, QW);
            }
        }
    }
    SEAM(3);
    if (IN(4)) {
        KP_INIT bf16_t* XN = WSP(bf16_t, WS_XN); bf16_t* Wg_t = WSP(bf16_t, WS_WG); bf16_t* QA = WSP(bf16_t, WS_QA); bf16_t* Qm = WSP(bf16_t, WS_Q); bf16_t* MG = WSP(bf16_t, WS_MG);
        pg8::Gemm g{XN, Wg_t, 1024}; pg8::StaticOrder S; S.init(T_TOK, NGATE, G, bx);
        pg8::EpiGate E{QA, Qm, QW, MG}; pg8::gemm_phase(lds, g, S, E);
    }
    SEAM(4);
    if (IN(5)) {
        KP_INIT const float* x = INP(0); float* out = OUTP; bf16_t* MG = WSP(bf16_t, WS_MG); bf16_t* Wout_t = WSP(bf16_t, WS_WOUT); bf16_t* HB = WSP(bf16_t, WS_HB);
        pg8::Gemm g{MG, Wout_t, 1024}; pg8::StaticOrder S; S.init(T_TOK, 1024, G, bx);
        pg8::EpiRes E{x, out, HB}; pg8::gemm_phase(lds, g, S, E);
    }
    SEAM(5);
    if (IN(6)) { PH_IDS
        KP_INIT const float* b_rg = INP(12); const float* b_re = INP(14); float* out = OUTP; float* WR = WSP(float, WS_WR); int* TOKE = WSP(int, WS_TOKE); int* TOKPOS = WSP(int, WS_TOKPOS); float* TOKCW = WSP(float, WS_TOKCW); float* TOKR = WSP(float, WS_TOKR);
        LAS float* wl = (LAS float*)lds;
        for (int i = tid; i < 20 * 256; i += NWAVES * 64) ((LAS f32x4*)wl)[i] = ((const f32x4*)WR)[i];
        __syncthreads();
        for (int m = gw; m < T_TOK; m += NGW) {
            const f32x4* hr = (const f32x4*)(out + (size_t)m * DM) + lane; f32x4 v[4]; float s = 0.f;
#pragma unroll
            for (int j = 0; j < 4; ++j) { v[j] = hr[64 * j]; s += (v[j].x * v[j].x + v[j].y * v[j].y) + (v[j].z * v[j].z + v[j].w * v[j].w); }
            const float r2 = __builtin_amdgcn_rsqf(wave_sum(s) * (1.f / DM) + EPS);
            float lg[20];
#pragma unroll
            for (int c = 0; c < 20; ++c) { float d = 0.f;
#pragma unroll
                for (int j = 0; j < 4; ++j) { const f32x4 w = ((const LAS f32x4*)wl)[c * 256 + 64 * j + lane]; d += (v[j].x * w.x + v[j].y * w.y) + (v[j].z * w.z + v[j].w * w.w); }
                lg[c] = wave_sum(d) * r2; asm volatile("" ::: "memory"); }
#pragma unroll
            for (int c = 0; c < 4; ++c) lg[c] += b_rg[c];
#pragma unroll
            for (int c = 0; c < 16; ++c) lg[4 + c] += b_re[c];
            int gi = 0; float gm = lg[0];
#pragma unroll
            for (int c = 1; c < 4; ++c) if (lg[c] > gm) { gm = lg[c]; gi = c; }
            float gs = 0.f;
#pragma unroll
            for (int c = 0; c < 4; ++c) gs += __expf(lg[c] - gm);
            const float g_w = 1.f / gs;
            float es[4];
#pragma unroll
            for (int k = 0; k < 4; ++k) es[k] = gi == 0 ? lg[4 + k] : gi == 1 ? lg[8 + k] : gi == 2 ? lg[12 + k] : lg[16 + k];
            int i0 = 0; float e0 = es[0];
#pragma unroll
            for (int k = 1; k < 4; ++k) if (es[k] > e0) { e0 = es[k]; i0 = k; }
            int i1 = -1; float e1 = -__builtin_inff();
#pragma unroll
            for (int k = 0; k < 4; ++k) if (k != i0 && es[k] > e1) { e1 = es[k]; i1 = k; }
            const float t1 = __expf(e1 - e0), w0 = 1.f / (1.f + t1), w1 = t1 * w0;
            if (lane == 0) {
                const int ex0 = gi * 4 + i0, ex1 = gi * 4 + i1;
                const int p0 = (int)__hip_atomic_fetch_add(ctl + CW_CNT + 64 * ex0, 1u, RLX_AGENT), p1 = (int)__hip_atomic_fetch_add(ctl + CW_CNT + 64 * ex1, 1u, RLX_AGENT);
                TOKE[m] = ex0 | (ex1 << 8); TOKPOS[2 * m] = p0; TOKPOS[2 * m + 1] = p1; TOKCW[2 * m] = w0 * g_w; TOKCW[2 * m + 1] = w1 * g_w; TOKR[m] = r2;
            }
        }
    }
    SEAM(6);
    if (IN(7)) { PH_IDS
        KP_INIT bf16_t* HB = WSP(bf16_t, WS_HB); bf16_t* XG = WSP(bf16_t, WS_XG); int* TOKE = WSP(int, WS_TOKE); int* TOKPOS = WSP(int, WS_TOKPOS); float* TOKCW = WSP(float, WS_TOKCW); float* TOKR = WSP(float, WS_TOKR); int* TOKSLOT = WSP(int, WS_TOKSLOT);
        float* RG = WSP(float, WS_RG); float* CWS = WSP(float, WS_CWS); int* META = WSP(int, WS_META);
        int off[NEXP]; int tot = 0;
#pragma unroll
        for (int e = 0; e < NEXP; ++e) { const int c = (int)__builtin_amdgcn_readfirstlane(__hip_atomic_load(ctl + CW_CNT + 64 * e, RLX_AGENT)); off[e] = tot; tot += (c + 255) >> 8; }
        if (bx == 0) { if (tid == 0) META[0] = tot;
            if (tid < MAXTILES) { int ee = 0;
#pragma unroll
                for (int e = 1; e < NEXP; ++e) if (tid >= off[e]) ee = e;
                META[16 + tid] = ee; } }
        for (int m = gw; m < T_TOK; m += NGW) {
            const int ee = TOKE[m], ex0 = ee & 255, ex1 = ee >> 8; int o0 = 0, o1 = 0;
#pragma unroll
            for (int e = 0; e < NEXP; ++e) { o0 = (e == ex0) ? off[e] : o0; o1 = (e == ex1) ? off[e] : o1; }
            const int s0 = o0 * 256 + TOKPOS[2 * m], s1 = o1 * 256 + TOKPOS[2 * m + 1];
            const u32x4* src = (const u32x4*)(HB + (size_t)m * DM) + lane; const u32x4 a = src[0], b2 = src[64];
            u32x4* d0 = (u32x4*)(XG + (size_t)s0 * DM) + lane; u32x4* d1 = (u32x4*)(XG + (size_t)s1 * DM) + lane;
            d0[0] = a; d0[64] = b2; d1[0] = a; d1[64] = b2;
            if (lane == 0) { const float r2 = TOKR[m]; RG[s0] = r2; RG[s1] = r2; CWS[s0] = TOKCW[2 * m]; CWS[s1] = TOKCW[2 * m + 1]; TOKSLOT[2 * m] = s0; TOKSLOT[2 * m + 1] = s1; }
        }
    }
    SEAM(7);
    if (IN(8)) {
        KP_INIT bf16_t* XG = WSP(bf16_t, WS_XG); bf16_t* Wei_t = WSP(bf16_t, WS_WEI); bf16_t* ACT = WSP(bf16_t, WS_ACT); float* RG = WSP(float, WS_RG); float* CWS = WSP(float, WS_CWS); int* META = WSP(int, WS_META);
        pg8::Gemm g{XG, Wei_t, 1024}; pg8::GroupedOrder S; S.init(META, 2, G, bx);
        pg8::EpiMoeIn E{RG, CWS, ACT}; pg8::gemm_phase(lds, g, S, E);
    }
    SEAM(8);
    if (IN(9)) {
        KP_INIT bf16_t* ACT = WSP(bf16_t, WS_ACT); bf16_t* Weo_t = WSP(bf16_t, WS_WEO); bf16_t* Y = WSP(bf16_t, WS_Y); int* META = WSP(int, WS_META);
        pg8::Gemm g{ACT, Weo_t, 256}; pg8::GroupedOrder S; S.init(META, 4, G, bx);
        pg8::EpiRows E{Y, DM, nullptr, 0.f, 1.f, 1 << 30, nullptr}; pg8::gemm_phase(lds, g, S, E);
    }
    SEAM(9);
    if (IN(10)) { PH_IDS
        KP_INIT float* out = OUTP; bf16_t* Y = WSP(bf16_t, WS_Y); bf16_t* HB = WSP(bf16_t, WS_HB); int* TOKSLOT = WSP(int, WS_TOKSLOT); float* SS2 = WSP(float, WS_SS2);
        for (int m = gw; m < T_TOK; m += NGW) {
            const int s0 = TOKSLOT[2 * m], s1 = TOKSLOT[2 * m + 1];
            f32x4* hr = (f32x4*)(out + (size_t)m * DM) + lane; const u32x2* y0 = (const u32x2*)(Y + (size_t)s0 * DM) + lane; const u32x2* y1 = (const u32x2*)(Y + (size_t)s1 * DM) + lane;
            u32x2* hb = (u32x2*)(HB + (size_t)m * DM) + lane; float s = 0.f;
#pragma unroll
            for (int j = 0; j < 4; ++j) { f32x4 v = hr[64 * j]; const u32x2 a = y0[64 * j], b2 = y1[64 * j];
                v.x += bf_lo(a.x) + bf_lo(b2.x); v.y += bf_hi(a.x) + bf_hi(b2.x); v.z += bf_lo(a.y) + bf_lo(b2.y); v.w += bf_hi(a.y) + bf_hi(b2.y);
                s += (v.x * v.x + v.y * v.y) + (v.z * v.z + v.w * v.w); hr[64 * j] = v;
                u32x2 w; w.x = cvt_pk_bf16(v.x, v.y); w.y = cvt_pk_bf16(v.z, v.w); hb[64 * j] = w; }
            s = wave_sum(s); if (lane == 0) SS2[m] = s;
        }
    }
    SEAM(10);
    if (IN(11)) {
        KP_INIT float* out = OUTP; bf16_t* HB = WSP(bf16_t, WS_HB); bf16_t* Wpg_t = WSP(bf16_t, WS_WPG); bf16_t* PP = WSP(bf16_t, WS_PP); float* SS2 = WSP(float, WS_SS2);
        pg8::Gemm g{HB, Wpg_t, 1024}; pg8::StaticOrder S; S.init(T_TOK, 1024, G, bx);
        pg8::EpiPle E{out, PP, SS2}; pg8::gemm_phase(lds, g, S, E);
    }
    SEAM(11);
    if (IN(12)) { PH_IDS
        KP_INIT float* out = OUTP; const float* g_fin = INP(20);
        for (int m = gw; m < T_TOK; m += NGW) {
            f32x4* hr = (f32x4*)(out + (size_t)m * DM) + lane; f32x4 v[4]; float s = 0.f;
#pragma unroll
            for (int j = 0; j < 4; ++j) { v[j] = hr[64 * j]; s += (v[j].x * v[j].x + v[j].y * v[j].y) + (v[j].z * v[j].z + v[j].w * v[j].w); }
            const float rs = __builtin_amdgcn_rsqf(wave_sum(s) * (1.f / DM) + EPS);
#pragma unroll
            for (int j = 0; j < 4; ++j) { const f32x4 gg = *((const f32x4*)g_fin + lane + 64 * j); hr[64 * j] = (f32x4){v[j].x * rs * gg.x, v[j].y * rs * gg.y, v[j].z * rs * gg.z, v[j].w * rs * gg.w}; }
        }
    }
#undef IN
#undef SEAM
#undef GRID_BAR
}

extern "C" void kernel_launch(void* const* d_in, const int* in_sizes, int n_in, void* d_out, int out_size, void* d_ws, size_t ws_size, hipStream_t stream) {
    static int grid = 0;
    if (grid == 0) {
        if (n_in != 21 || in_sizes[0] != T_TOK * DM || out_size != T_TOK * DM || ws_size < WS_END) { fprintf(stderr, "kernel_launch: unexpected shapes (n_in %d, in0 %d, out %d, ws %zu)\n", n_in, n_in > 0 ? in_sizes[0] : -1, out_size, ws_size); grid = -1; return; }
        int dev = 0, cus = 0, per_cu = 0;
        if (hipGetDevice(&dev) != hipSuccess || hipDeviceGetAttribute(&cus, hipDeviceAttributeMultiprocessorCount, dev) != hipSuccess) { grid = -1; return; }
        if (hipFuncSetAttribute((const void*)mk_fwd, hipFuncAttributeMaxDynamicSharedMemorySize, LDS_BYTES) != hipSuccess) { fprintf(stderr, "kernel_launch: hipFuncSetAttribute failed\n"); grid = -1; return; }
        if (hipOccupancyMaxActiveBlocksPerMultiprocessor(&per_cu, (const void*)mk_fwd, NWAVES * 64, LDS_BYTES) != hipSuccess || per_cu < 1) { fprintf(stderr, "kernel_launch: occupancy query says %d blocks per CU\n", per_cu); (void)hipGetLastError(); grid = -1; return; }
        grid = cus;
    }
    if (grid < 0) return;
    (void)hipMemsetAsync((char*)d_ws + WS_CTL, 0, CTL_ZERO_BYTES, stream);
    Args a{};
    for (int i = 0; i < 21; ++i) a.in[i] = (const float*)d_in[i];
    a.out = (float*)d_out; a.ws = (unsigned char*)d_ws;
#if MK_ONE_LAUNCH
    a.ph_lo = 0; a.ph_hi = NPHASE;
    hipLaunchKernelGGL(mk_fwd, dim3(grid), dim3(NWAVES * 64), LDS_BYTES, stream, a);
#else
    for (int ph = 0; ph < NPHASE; ++ph) { a.ph_lo = ph; a.ph_hi = ph + 1; hipLaunchKernelGGL(mk_fwd, dim3(grid), dim3(NWAVES * 64), LDS_BYTES, stream, a); }
#endif
}
```

```cpp
#include <hip/hip_runtime.h>
#include <hip/hip_bf16.h>
#include <cstdio>
#include <cstdint>

#ifndef MK_ONE_LAUNCH
#define MK_ONE_LAUNCH 1
#endif

#ifndef PROBE_LO
#define PROBE_LO -1
#define PROBE_HI -1
#endif
#ifndef PROBE_MUL
#define PROBE_MUL 3
#endif
#ifndef PROBE_ATT
#define PROBE_ATT -1
#endif
#define LAS __attribute__((address_space(3)))
#define GAS __attribute__((address_space(1)))
typedef unsigned short bf16_t;
typedef short bf16x8 __attribute__((ext_vector_type(8)));
typedef short s16x4 __attribute__((ext_vector_type(4)));
typedef float f32x2 __attribute__((ext_vector_type(2)));
typedef float f32x4 __attribute__((ext_vector_type(4)));
typedef float f32x16 __attribute__((ext_vector_type(16)));
typedef unsigned u32x2 __attribute__((ext_vector_type(2)));
typedef unsigned u32x4 __attribute__((ext_vector_type(4)));

constexpr int T_TOK = 16384, SEQ = 8192, DM = 1024;
constexpr int N1 = 1792;
constexpr int NGATE = 2048;
constexpr int QW = 1536, KVW = 2048;
constexpr int NEXP = 16, DEXP = 256;
constexpr int MAXTILES = 144, MAXSLOTS = MAXTILES * 256;
constexpr float EPS = 1e-6f;
constexpr float LOG2E = 1.4426950408889634f;
constexpr float C2SWA = 0.125f * LOG2E;
constexpr float C2MLA = 0.07216878364870322f * LOG2E;

__device__ __forceinline__ unsigned cvt_pk_bf16(float lo, float hi) { unsigned r; asm volatile("v_cvt_pk_bf16_f32 %0, %1, %2" : "=v"(r) : "v"(lo), "v"(hi)); return r; }
__device__ __forceinline__ float bf_lo(unsigned w) { return __uint_as_float(w << 16); }
__device__ __forceinline__ float bf_hi(unsigned w) { return __uint_as_float(w & 0xffff0000u); }
__device__ __forceinline__ float fsigmoid(float x) { return __builtin_amdgcn_rcpf(1.f + __builtin_amdgcn_exp2f(-x * LOG2E)); }
__device__ __forceinline__ int opaque_tid() { int t = threadIdx.x; asm volatile("" : "+v"(t)); return t; }
__device__ __forceinline__ float wave_sum(float v) {
#pragma unroll
    for (int o = 1; o < 64; o <<= 1) v += __shfl_xor(v, o);
    return v;
}

namespace pg8 {
constexpr int BM = 256, BK = 64, HALF = 128, HTB = HALF * BK * 2, STAGE_BYTES = 8 * HTB, NXCD = 8, WGM = 8;
__host__ __device__ __forceinline__ int lds_byte(int r, int c) { const int st = (r >> 4) * 2 + (c >> 5), rr = r & 15, cc = c & 31, ob = rr * 64 + cc * 2; return st * 1024 + (ob ^ (((ob >> 9) & 1) << 5)); }
__host__ __device__ __forceinline__ void stage_rc(int b, int& R, int& C) { const int st = b / 1024, sb = b % 1024, swz = sb ^ (((sb >> 9) & 1) << 5); R = (st >> 1) * 16 + swz / 64; C = (st & 1) * 32 + (swz % 64) / 2; }
__host__ __device__ __forceinline__ int perm32(int rho) { const int n = rho >> 4, i = rho & 15; return 8 * (i >> 2) + 4 * n + (i & 3); }

struct Unit { int pm, pn, pb; };
struct Gemm { const bf16_t* A; const bf16_t* Bt; int K; };

struct StaticOrder {
    int nM, nN, nwg, G, c;
    __device__ __forceinline__ void init(int M, int N, int G_, int c_) { nM = M / BM; nN = N / BM; nwg = nM * nN; G = G_; c = c_; }
    __device__ __forceinline__ bool next(int i, Unit& u) const {
        const long L = (long)i * G + c; if (L >= nwg) return false;
        int wgid = (int)L; { const int q = nwg / NXCD, r = nwg % NXCD, xcd = wgid % NXCD, off = wgid / NXCD; wgid = (xcd < r ? xcd * (q + 1) : r * (q + 1) + (xcd - r) * q) + off; }
        const int nig = WGM * nN, gid = wgid / nig, fm = gid * WGM, gsz = (nM - fm) < WGM ? (nM - fm) : WGM;
        u.pm = fm + ((wgid % nig) % gsz); u.pn = (wgid % nig) / gsz; u.pb = u.pn; return true;
    }
};
struct GroupedOrder {
    const int* meta; int npn, G, c, ntiles;
    __device__ __forceinline__ void init(const int* meta_, int npn_, int G_, int c_) {
        meta = meta_; npn = npn_; G = G_; c = c_;
        ntiles = __builtin_amdgcn_readfirstlane(__hip_atomic_load(meta, __ATOMIC_RELAXED, __HIP_MEMORY_SCOPE_AGENT));
        if (ntiles > MAXTILES) ntiles = MAXTILES;
    }
    __device__ __forceinline__ bool next(int i, Unit& u) const {
        const int L = i * G + c; if (L >= ntiles * npn) return false;
        u.pm = L / npn; u.pn = L % npn;
        const int e = __builtin_amdgcn_readfirstlane(__hip_atomic_load(meta + 16 + u.pm, __ATOMIC_RELAXED, __HIP_MEMORY_SCOPE_AGENT));
        u.pb = e * npn + u.pn; return true;
    }
};

typedef f32x4 Acc[2][2][4][2];

template <class Epi, class Sched>
__device__ __forceinline__ void gemm_phase(LAS unsigned char* lds, const Gemm g, const Sched& S, const Epi& E) {
    const int tid = opaque_tid(), wid = __builtin_amdgcn_readfirstlane(tid >> 6), lane = tid & 63, wr = wid >> 2, wc = wid & 3, fr = lane & 15, fq = lane >> 4;
    const int K = g.K, nt = K / BK;
    unsigned voffA[2], voffB[2];
#pragma unroll
    for (int i = 0; i < 2; ++i) { int R, C; stage_rc(tid * 16 + i * 8192, R, C); const int Rb = (R & ~31) + perm32(R & 31);
        voffA[i] = (unsigned)(R * K + C) * 2u; voffB[i] = (unsigned)(Rb * K + C) * 2u; }
    const size_t kstep = (size_t)(BK * 2);
    const size_t hstep = (size_t)HALF * K * 2;
    const size_t tstep = 2 * hstep;
    const unsigned ldsw = (unsigned)wid * 1024u;
    const int aoff = lds_byte(wr * 64 + fr, fq * 8), boff = lds_byte(wc * 32 + fr, fq * 8);
#define PG8_SA(b, h) (((b) * 2 + (h)) * HTB)
#define PG8_SB(b, h) ((4 + (b) * 2 + (h)) * HTB)
#define PG8_STAGE(bufoff, gbase, voff) do { _Pragma("unroll") for (int _i = 0; _i < 2; ++_i) \
        __builtin_amdgcn_global_load_lds((const unsigned*)((const char*)(gbase) + (voff)[_i]), (LAS unsigned*)(lds + (bufoff) + ldsw + _i * 8192), 16, 0, 0); } while (0)
#define PG8_LDA(dst, b, h) do { _Pragma("unroll") for (int m = 0; m < 4; ++m) _Pragma("unroll") for (int k = 0; k < 2; ++k) dst[m][k] = *(const LAS bf16x8*)(lds + PG8_SA(b, h) + aoff + m * 2048 + k * 1024); } while (0)
#define PG8_LDB(dst, b, h) do { _Pragma("unroll") for (int n = 0; n < 2; ++n) _Pragma("unroll") for (int k = 0; k < 2; ++k) dst[n][k] = *(const LAS bf16x8*)(lds + PG8_SB(b, h) + boff + n * 2048 + k * 1024); } while (0)
#define PG8_MMA(ai, bj, At, Bt) do { __builtin_amdgcn_s_setprio(1); _Pragma("unroll") for (int m = 0; m < 4; ++m) _Pragma("unroll") for (int n = 0; n < 2; ++n) _Pragma("unroll") for (int k = 0; k < 2; ++k) \
        acc[ai][bj][m][n] = __builtin_amdgcn_mfma_f32_16x16x32_bf16(Bt[n][k], At[m][k], acc[ai][bj][m][n], 0, 0, 0); __builtin_amdgcn_s_setprio(0); } while (0)
#define PG8_WAIT_V(n) asm volatile("s_waitcnt vmcnt(" #n ")" ::: "memory")
#define PG8_WAIT_L(n) asm volatile("s_waitcnt lgkmcnt(" #n ")" ::: "memory")
#define PG8_BAR __builtin_amdgcn_s_barrier()
#define PG8_SCHED __builtin_amdgcn_sched_barrier(0)
    Unit cur, nxt; int ui = 0;
    if (!S.next(0, cur)) return;
    Acc acc;
#pragma unroll
    for (int a = 0; a < 2; ++a)
#pragma unroll
        for (int b = 0; b < 2; ++b)
#pragma unroll
            for (int m = 0; m < 4; ++m)
#pragma unroll
                for (int n = 0; n < 2; ++n) acc[a][b][m][n] = (f32x4){0.f, 0.f, 0.f, 0.f};
    bf16x8 At[4][2], B0[2][2], B1[2][2];
    const char* cA = (const char*)g.A + (size_t)cur.pm * tstep; const char* cB = (const char*)g.Bt + (size_t)cur.pb * tstep;
    PG8_STAGE(PG8_SB(0, 0), cB, voffB); PG8_STAGE(PG8_SB(0, 1), cB + hstep, voffB); PG8_STAGE(PG8_SA(0, 0), cA, voffA); PG8_STAGE(PG8_SA(0, 1), cA + hstep, voffA);
    if (wr == 1) PG8_BAR;
    PG8_WAIT_V(2); PG8_BAR;
    PG8_STAGE(PG8_SB(1, 0), cB + kstep, voffB); PG8_STAGE(PG8_SA(1, 0), cA + kstep, voffA); PG8_STAGE(PG8_SB(1, 1), cB + hstep + kstep, voffB);
    PG8_WAIT_V(6); PG8_BAR;
    for (;;) {
        const bool has_next = S.next(ui + 1, nxt);
        const char* nA = has_next ? (const char*)g.A + (size_t)nxt.pm * tstep : cA; const char* nB = has_next ? (const char*)g.Bt + (size_t)nxt.pb * tstep : cB;
        for (int t = 0; t < nt; t += 2) {
            const bool last = (t == nt - 2);
            const char* a1 = cA + (size_t)(t + 1) * kstep;
            const char* a2 = last ? nA : cA + (size_t)(t + 2) * kstep; const char* b2 = last ? nB : cB + (size_t)(t + 2) * kstep;
            const char* a3 = a2 + kstep; const char* b3 = b2 + kstep;
            PG8_LDB(B0, 0, 0); PG8_LDB(B1, 0, 1); PG8_SCHED; PG8_LDA(At, 0, 0); PG8_STAGE(PG8_SA(1, 1), a1 + hstep, voffA);
            PG8_WAIT_V(8); PG8_WAIT_L(0); PG8_BAR; PG8_MMA(0, 0, At, B0); PG8_MMA(0, 1, At, B1); PG8_BAR; PG8_SCHED;
            PG8_LDA(At, 0, 1); PG8_STAGE(PG8_SB(0, 0), b2, voffB); PG8_STAGE(PG8_SB(0, 1), b2 + hstep, voffB); PG8_STAGE(PG8_SA(0, 0), a2, voffA);
            PG8_WAIT_V(8); PG8_WAIT_L(0); PG8_BAR; PG8_MMA(1, 0, At, B0); PG8_MMA(1, 1, At, B1); PG8_BAR; PG8_SCHED;
            PG8_LDB(B0, 1, 0); PG8_LDB(B1, 1, 1); PG8_SCHED; PG8_LDA(At, 1, 0); PG8_STAGE(PG8_SA(0, 1), a2 + hstep, voffA);
            PG8_WAIT_V(8); PG8_WAIT_L(0); PG8_BAR; PG8_MMA(0, 0, At, B0); PG8_MMA(0, 1, At, B1); PG8_BAR; PG8_SCHED;
            PG8_LDA(At, 1, 1); PG8_STAGE(PG8_SB(1, 0), b3, voffB); PG8_STAGE(PG8_SB(1, 1), b3 + hstep, voffB); PG8_STAGE(PG8_SA(1, 0), a3, voffA);
            PG8_WAIT_V(8); PG8_WAIT_L(0); PG8_BAR; PG8_MMA(1, 0, At, B0); PG8_MMA(1, 1, At, B1); PG8_BAR; PG8_SCHED;
        }
        if (wr == 0) PG8_BAR;
        E(acc, cur, wr, wc, fr, fq);
        if (!has_next) break;
#pragma unroll
        for (int a = 0; a < 2; ++a)
#pragma unroll
            for (int b = 0; b < 2; ++b)
#pragma unroll
                for (int m = 0; m < 4; ++m)
#pragma unroll
                    for (int n = 0; n < 2; ++n) acc[a][b][m][n] = (f32x4){0.f, 0.f, 0.f, 0.f};
        cur = nxt; cA = nA; cB = nB; ++ui;
        if (wr == 1) PG8_BAR;
    }
    PG8_WAIT_V(0);
    PG8_BAR;
#undef PG8_SA
#undef PG8_SB
#undef PG8_STAGE
#undef PG8_LDA
#undef PG8_LDB
#undef PG8_MMA
#undef PG8_WAIT_V
#undef PG8_WAIT_L
#undef PG8_BAR
#undef PG8_SCHED
}

__device__ __forceinline__ u32x4 pack8(f32x4 a, f32x4 b) { u32x4 w; w.x = cvt_pk_bf16(a[0], a[1]); w.y = cvt_pk_bf16(a[2], a[3]); w.z = cvt_pk_bf16(b[0], b[1]); w.w = cvt_pk_bf16(b[2], b[3]); return w; }
__device__ __forceinline__ void rope8(f32x4& a, f32x4& b, const float* tabrow, int i0) {
    const f32x4 t0 = *(const f32x4*)(tabrow + 2 * i0), t1 = *(const f32x4*)(tabrow + 2 * i0 + 4);
    const float a0 = a[0] * t0[0] - a[1] * t0[1], a1 = a[1] * t0[0] + a[0] * t0[1];
    const float a2 = a[2] * t0[2] - a[3] * t0[3], a3 = a[3] * t0[2] + a[2] * t0[3];
    const float b0 = b[0] * t1[0] - b[1] * t1[1], b1 = b[1] * t1[0] + b[0] * t1[1];
    const float b2 = b[2] * t1[2] - b[3] * t1[3], b3 = b[3] * t1[2] + b[2] * t1[3];
    a = (f32x4){a0, a1, a2, a3}; b = (f32x4){b0, b1, b2, b3};
}
__device__ __forceinline__ float sq8(f32x4 a, f32x4 b) { return (a[0] * a[0] + a[1] * a[1]) + (a[2] * a[2] + a[3] * a[3]) + (b[0] * b[0] + b[1] * b[1]) + (b[2] * b[2] + b[3] * b[3]); }

struct EpiIn {
    bf16_t* Qa; bf16_t* KVa; bf16_t* CQ; bf16_t* CKV; bf16_t* KR; float* SSQ; float* SSKV; const float* rope;
    __device__ __forceinline__ void operator()(const Acc& acc, const Unit& u, int wr, int wc, int, int) const {
        const int lane_ = opaque_tid() & 63, fr = lane_ & 15, fq = lane_ >> 4;
        const int row0 = u.pm * BM + wr * 64 + fr, c8 = wc * 32 + 8 * fq;
#pragma unroll
        for (int ai = 0; ai < 2; ++ai)
#pragma unroll
            for (int m = 0; m < 4; ++m) {
                const int row = row0 + ai * HALF + m * 16; const float* tab = rope + (size_t)(row & (SEQ - 1)) * 64;
                if (u.pn < 4) {
#pragma unroll
                    for (int bj = 0; bj < 2; ++bj) { f32x4 a = acc[ai][bj][m][0], b = acc[ai][bj][m][1]; const int col = bj * HALF + c8;
                        rope8(a, b, tab, (col & 63) >> 1); a = a * C2SWA; b = b * C2SWA;
                        *(u32x4*)(Qa + (size_t)row * DM + u.pn * BM + col) = pack8(a, b); }
                } else if (u.pn == 4) {
                    { f32x4 a = acc[ai][0][m][0], b = acc[ai][0][m][1]; rope8(a, b, tab, (c8 & 63) >> 1); *(u32x4*)(KVa + (size_t)row * 256 + c8) = pack8(a, b); }
                    { *(u32x4*)(KVa + (size_t)row * 256 + HALF + c8) = pack8(acc[ai][1][m][0], acc[ai][1][m][1]); }
                } else if (u.pn == 5) {
                    float s = 0.f;
#pragma unroll
                    for (int bj = 0; bj < 2; ++bj) { const f32x4 a = acc[ai][bj][m][0], b = acc[ai][bj][m][1]; s += sq8(a, b);
                        *(u32x4*)(CQ + (size_t)row * 256 + bj * HALF + c8) = pack8(a, b); }
                    s += __shfl_xor(s, 16); s += __shfl_xor(s, 32);
                    if (fq == 0) SSQ[(size_t)row * 4 + wc] = s;
                } else {
                    { const f32x4 a = acc[ai][0][m][0], b = acc[ai][0][m][1]; float s = sq8(a, b);
                      *(u32x4*)(CKV + (size_t)row * 128 + c8) = pack8(a, b);
                      s += __shfl_xor(s, 16); s += __shfl_xor(s, 32);
                      if (fq == 0) SSKV[(size_t)row * 4 + wc] = s; }
                    if (wc < 2) { f32x4 a = acc[ai][1][m][0], b = acc[ai][1][m][1]; rope8(a, b, tab, c8 >> 1); *(u32x4*)(KR + (size_t)row * 64 + c8) = pack8(a, b); }
                }
            }
    }
};
struct EpiRows {
    bf16_t* O; int ldc; const float* SS; float inv_n; float mul; int rope_pn0; const float* rope;
    __device__ __forceinline__ void operator()(const Acc& acc, const Unit& u, int wr, int wc, int, int) const {
        const int lane_ = opaque_tid() & 63, fr = lane_ & 15, fq = lane_ >> 4;
        const int row0 = u.pm * BM + wr * 64 + fr, c8 = wc * 32 + 8 * fq;
#pragma unroll
        for (int ai = 0; ai < 2; ++ai)
#pragma unroll
            for (int m = 0; m < 4; ++m) {
                const int row = row0 + ai * HALF + m * 16;
                float r = mul;
                if (SS) { const f32x4 s4 = *(const f32x4*)(SS + (size_t)row * 4); r = mul * __builtin_amdgcn_rsqf(((s4[0] + s4[1]) + (s4[2] + s4[3])) * inv_n + EPS); }
#pragma unroll
                for (int bj = 0; bj < 2; ++bj) { f32x4 a = acc[ai][bj][m][0] * r, b = acc[ai][bj][m][1] * r; const int col = bj * HALF + c8;
                    if (u.pn >= rope_pn0) rope8(a, b, rope + (size_t)(row & (SEQ - 1)) * 64, (col & 63) >> 1);
                    *(u32x4*)(O + (size_t)row * ldc + u.pn * BM + col) = pack8(a, b); }
            }
    }
};
struct EpiGate {
    const bf16_t* OA; const bf16_t* OB; int ldb; bf16_t* MG;
    __device__ __forceinline__ void operator()(const Acc& acc, const Unit& u, int wr, int wc, int, int) const {
        const int lane_ = opaque_tid() & 63, fr = lane_ & 15, fq = lane_ >> 4;
        const int row0 = u.pm * BM + wr * 64 + fr, col = u.pn * HALF + wc * 32 + 8 * fq;
#pragma unroll
        for (int ai = 0; ai < 2; ++ai)
#pragma unroll
            for (int m = 0; m < 4; ++m) {
                const int row = row0 + ai * HALF + m * 16;
                const u32x4 oa = *(const u32x4*)(OA + (size_t)row * DM + col), ob = *(const u32x4*)(OB + (size_t)row * ldb + col);
                f32x4 r0, r1;
#pragma unroll
                for (int j = 0; j < 4; ++j) {
                    const float ga = fsigmoid(acc[ai][0][m][j >> 1][(j & 1) * 2]), ga1 = fsigmoid(acc[ai][0][m][j >> 1][(j & 1) * 2 + 1]);
                    const float gb = fsigmoid(acc[ai][1][m][j >> 1][(j & 1) * 2]), gb1 = fsigmoid(acc[ai][1][m][j >> 1][(j & 1) * 2 + 1]);
                    const float v0 = ga * bf_lo(oa[j]) + gb * bf_lo(ob[j]), v1 = ga1 * bf_hi(oa[j]) + gb1 * bf_hi(ob[j]);
                    if (j < 2) { r0[2 * j] = v0; r0[2 * j + 1] = v1; } else { r1[2 * (j - 2)] = v0; r1[2 * (j - 2) + 1] = v1; }
                }
                *(u32x4*)(MG + (size_t)row * DM + col) = pack8(r0, r1);
            }
    }
};
struct EpiRes {
    const float* X; float* H; bf16_t* HB;
    __device__ __forceinline__ void operator()(const Acc& acc, const Unit& u, int wr, int wc, int, int) const {
        const int lane_ = opaque_tid() & 63, fr = lane_ & 15, fq = lane_ >> 4;
        const int row0 = u.pm * BM + wr * 64 + fr, c8 = wc * 32 + 8 * fq;
#pragma unroll
        for (int ai = 0; ai < 2; ++ai)
#pragma unroll
            for (int m = 0; m < 4; ++m) {
                const int row = row0 + ai * HALF + m * 16;
#pragma unroll
                for (int bj = 0; bj < 2; ++bj) { const size_t off = (size_t)row * DM + u.pn * BM + bj * HALF + c8;
                    const f32x4 a = *(const f32x4*)(X + off) + acc[ai][bj][m][0], b = *(const f32x4*)(X + off + 4) + acc[ai][bj][m][1];
                    *(f32x4*)(H + off) = a; *(f32x4*)(H + off + 4) = b; *(u32x4*)(HB + off) = pack8(a, b); }
            }
    }
};
struct EpiMoeIn {
    const float* RG; const float* CW; bf16_t* ACT;
    __device__ __forceinline__ void operator()(const Acc& acc, const Unit& u, int wr, int wc, int, int) const {
        const int lane_ = opaque_tid() & 63, fr = lane_ & 15, fq = lane_ >> 4;
        const int row0 = u.pm * BM + wr * 64 + fr, col = u.pn * HALF + wc * 32 + 8 * fq;
#pragma unroll
        for (int ai = 0; ai < 2; ++ai)
#pragma unroll
            for (int m = 0; m < 4; ++m) {
                const int row = row0 + ai * HALF + m * 16; const float r = RG[row], cw = CW[row];
                f32x4 o[2];
#pragma unroll
                for (int n = 0; n < 2; ++n)
#pragma unroll
                    for (int j = 0; j < 4; ++j) { const float gt = r * acc[ai][0][m][n][j], up = r * acc[ai][1][m][n][j]; o[n][j] = gt * fsigmoid(gt) * up * cw; }
                *(u32x4*)(ACT + (size_t)row * DEXP + col) = pack8(o[0], o[1]);
            }
    }
};
struct EpiPle {
    float* H; const bf16_t* PP; const float* SS2;
    __device__ __forceinline__ void operator()(const Acc& acc, const Unit& u, int wr, int wc, int, int) const {
        const int lane_ = opaque_tid() & 63, fr = lane_ & 15, fq = lane_ >> 4;
        const int row0 = u.pm * BM + wr * 64 + fr, c8 = wc * 32 + 8 * fq;
#pragma unroll
        for (int ai = 0; ai < 2; ++ai)
#pragma unroll
            for (int m = 0; m < 4; ++m) {
                const int row = row0 + ai * HALF + m * 16; const float r = __builtin_amdgcn_rsqf(SS2[row] * (1.f / DM) + EPS);
#pragma unroll
                for (int bj = 0; bj < 2; ++bj) { const size_t off = (size_t)row * DM + u.pn * BM + bj * HALF + c8;
                    const u32x4 pp = *(const u32x4*)(PP + off); f32x4 a = *(const f32x4*)(H + off), b = *(const f32x4*)(H + off + 4);
                    const f32x4 g0 = acc[ai][bj][m][0] * r, g1 = acc[ai][bj][m][1] * r;
                    a[0] += fsigmoid(g0[0]) * bf_lo(pp[0]); a[1] += fsigmoid(g0[1]) * bf_hi(pp[0]); a[2] += fsigmoid(g0[2]) * bf_lo(pp[1]); a[3] += fsigmoid(g0[3]) * bf_hi(pp[1]);
                    b[0] += fsigmoid(g1[0]) * bf_lo(pp[2]); b[1] += fsigmoid(g1[1]) * bf_hi(pp[2]); b[2] += fsigmoid(g1[2]) * bf_lo(pp[3]); b[3] += fsigmoid(g1[3]) * bf_hi(pp[3]);
                    *(f32x4*)(H + off) = a; *(f32x4*)(H + off + 4) = b; }
            }
    }
};
}

namespace att {
__device__ __forceinline__ int v_st(int k, int c) { const int kk = (k & ~0xC) | ((k & 4) << 1) | ((k & 8) >> 1); return ((kk >> 3) * 4 + (c >> 5)) * 512 + ((kk & 7) * 32 + (c & 31)) * 2; }
__device__ __forceinline__ int v_rd_base(int lane) { return ((lane & 3) << 3) | (((lane >> 2) & 3) << 6) | (((lane >> 4) & 1) << 5) | (((lane >> 5) & 1) << 8); }
__device__ __forceinline__ int crow(int r, int hi) { return (r & 3) + 8 * (r >> 2) + 4 * hi; }
typedef short v4i16_t __attribute__((ext_vector_type(4)));
__device__ __forceinline__ s16x4 vtr(const LAS char* p) { return __builtin_bit_cast(s16x4, __builtin_amdgcn_ds_read_tr16_b64_v4i16((LAS v4i16_t*)p)); }
__device__ __forceinline__ void mask_tile(f32x16& p0, f32x16& p1, int dq, unsigned W) {
    const float NEG = -__builtin_inff();
#pragma unroll
    for (int r = 0; r < 16; ++r) {
        const int c = (r & 3) + 8 * (r >> 2);
        if ((unsigned)(dq - c) >= W) p0[r] = NEG;
        if ((unsigned)(dq - c - 32) >= W) p1[r] = NEG;
    }
}
constexpr float THR = 10.f;
template <int DQK, int DV> struct Geo { static constexpr int KROW = DQK * 2 + 16, KBUF = 64 * KROW, VBUF = 16384, LDS_V = 2 * KBUF, LDS_S = LDS_V + 2 * VBUF, LDS_BYTES = LDS_S + 8 * 256; };

template <int DQK, int DV, int K1W, int VAR = 0>
__device__ __forceinline__ void attn_unit(LAS char* lds, const bf16_t* q1, const bf16_t* q2, int QP,
                                          const bf16_t* K1, int K1P, const bf16_t* K2, int K2P, const bf16_t* Vp, int VP,
                                          int j_lo, int j_hi, int qlo, unsigned W, float m0, float l0, bf16_t* ow, int OP) {
    typedef Geo<DQK, DV> G;
    constexpr int NQF = DQK / 16, ND0 = DV / 32, K1C = K1W / 8, K2C = (DQK - K1W) / 8, VC = DV / 8;
    constexpr int NK1 = (64 * K1C) / 512, NK2 = (64 * K2C + 511) / 512, NV = (64 * VC) / 512;
    static_assert(NK1 >= 1 && NK1 <= 2 && NK2 <= 1 && NV >= 1 && NV <= 2, "staging geometry");
    const int tid = opaque_tid(), lane = tid & 63, r32 = lane & 31, hi = lane >> 5; const int wid = __builtin_amdgcn_readfirstlane(tid >> 6);
    LAS float* wsf = (LAS float*)(lds + G::LDS_S) + wid * 64;
    bf16x8 qr[NQF];
#pragma unroll
    for (int d0 = 0; d0 < NQF; ++d0) {
        if (d0 * 16 < K1W) qr[d0] = *(const bf16x8*)(q1 + (size_t)r32 * QP + d0 * 16 + hi * 8);
        else qr[d0] = *(const bf16x8*)(q2 + (size_t)r32 * QP + (d0 * 16 - K1W) + hi * 8);
    }
    const int k1r = tid / K1C, k1c = tid % K1C;
    const int k2r = K2C ? tid / (K2C ? K2C : 1) : 0, k2c = K2C ? tid % (K2C ? K2C : 1) : 0;
    const int vr = tid / VC, vc = tid % VC;
    bf16x8 sk1[NK1], sk2[NK2 ? NK2 : 1], sv[NV];
#define ATT_LOAD(kb) do { \
        _Pragma("unroll") for (int i = 0; i < NK1; ++i) sk1[i] = *(const bf16x8*)(K1 + (size_t)((kb) + k1r + i * (512 / K1C)) * K1P + k1c * 8); \
        if (NK2) sk2[0] = *(const bf16x8*)(K2 + (size_t)((kb) + k2r) * K2P + k2c * 8); \
        _Pragma("unroll") for (int i = 0; i < NV; ++i) sv[i] = *(const bf16x8*)(Vp + (size_t)((kb) + vr + i * (512 / VC)) * VP + vc * 8); } while (0)
#define ATT_WRITE(buf) do { \
        _Pragma("unroll") for (int i = 0; i < NK1; ++i) *(LAS bf16x8*)(lds + (buf) * G::KBUF + (k1r + i * (512 / K1C)) * G::KROW + k1c * 16) = sk1[i]; \
        if (NK2) *(LAS bf16x8*)(lds + (buf) * G::KBUF + k2r * G::KROW + (K1C + k2c) * 16) = sk2[0]; \
        _Pragma("unroll") for (int i = 0; i < NV; ++i) *(LAS bf16x8*)(lds + G::LDS_V + (buf) * G::VBUF + v_st(vr + i * (512 / VC), vc * 8)) = sv[i]; } while (0)
    float m_reg = m0, l_reg = l0;
    f32x16 o[ND0];
#pragma unroll
    for (int d = 0; d < ND0; ++d) o[d] = f32x16{};
    const int qm = qlo + r32 - 4 * hi;
    const int NT = j_hi - j_lo;
    ATT_LOAD(j_lo * 64);
    ATT_WRITE(0);
    __syncthreads();
#pragma unroll
    for (int d0 = 0; d0 < NQF; ++d0) asm volatile("" : "+v"(qr[d0]));
    const LAS char* kp0 = lds + r32 * G::KROW + hi * 16;
    const LAS char* vp0 = lds + G::LDS_V + v_rd_base(lane);
    for (int t = 0; t < NT; ++t) {
        const int buf = t & 1, kb = (j_lo + t) * 64;
        if (VAR != 3 && t + 1 < NT) ATT_LOAD(kb + 64);
        f32x16 p0 = f32x16{}, p1 = f32x16{};
        if (VAR != 5) { const LAS char* kp = kp0 + buf * G::KBUF;
#pragma unroll
          for (int d0 = 0; d0 < NQF; ++d0) {
              const bf16x8 b0 = *(const LAS bf16x8*)(kp + d0 * 32), b1 = *(const LAS bf16x8*)(kp + 32 * G::KROW + d0 * 32);
              p0 = __builtin_amdgcn_mfma_f32_32x32x16_bf16(b0, qr[d0], p0, 0, 0, 0);
              p1 = __builtin_amdgcn_mfma_f32_32x32x16_bf16(b1, qr[d0], p1, 0, 0, 0); } }
        if (kb + 63 > qlo || (long)kb <= (long)qlo + 31 - (long)W) mask_tile(p0, p1, qm - kb, W);
        float alpha = 1.f;
        if (VAR != 2) {
        float pmax = p0[0];
#pragma unroll
        for (int r = 1; r < 16; ++r) pmax = fmaxf(pmax, p0[r]);
#pragma unroll
        for (int r = 0; r < 16; ++r) pmax = fmaxf(pmax, p1[r]);
        { auto rr = __builtin_amdgcn_permlane32_swap(__float_as_uint(pmax), __float_as_uint(pmax), false, false);
          pmax = fmaxf(__uint_as_float(rr[0]), __uint_as_float(rr[1])); }
        if (!__all(pmax - m_reg <= THR)) {
            const float mn = fmaxf(m_reg, pmax); alpha = __builtin_amdgcn_exp2f(m_reg - mn); m_reg = mn;
            if (hi == 0) wsf[r32] = alpha;
#pragma unroll
            for (int d = 0; d < ND0; ++d)
#pragma unroll
                for (int r = 0; r < 16; ++r) o[d][r] *= wsf[crow(r, hi)];
        }
        float ps = 0.f;
#pragma unroll
        for (int r = 0; r < 16; ++r) { p0[r] = (VAR == 1) ? (p0[r] - m_reg) : __builtin_amdgcn_exp2f(p0[r] - m_reg); ps += p0[r]; }
#pragma unroll
        for (int r = 0; r < 16; ++r) { p1[r] = (VAR == 1) ? (p1[r] - m_reg) : __builtin_amdgcn_exp2f(p1[r] - m_reg); ps += p1[r]; }
        { auto rr = __builtin_amdgcn_permlane32_swap(__float_as_uint(ps), __float_as_uint(ps), false, false);
          ps = __uint_as_float(rr[0]) + __uint_as_float(rr[1]); }
        l_reg = l_reg * alpha + ps;
        }
        bf16x8 pa0, pa1, pa2, pa3;
#define PK4(P, B_, OUT) do { unsigned a0 = cvt_pk_bf16(P[B_+0], P[B_+1]), a1 = cvt_pk_bf16(P[B_+2], P[B_+3]); \
        unsigned b0_ = cvt_pk_bf16(P[B_+4], P[B_+5]), b1_ = cvt_pk_bf16(P[B_+6], P[B_+7]); \
        auto r0 = __builtin_amdgcn_permlane32_swap(a0, b0_, false, false); auto r1 = __builtin_amdgcn_permlane32_swap(a1, b1_, false, false); \
        u32x4 w = {r0[0], r1[0], r0[1], r1[1]}; OUT = __builtin_bit_cast(bf16x8, w); } while (0)
        PK4(p0, 0, pa0); PK4(p0, 8, pa1); PK4(p1, 0, pa2); PK4(p1, 8, pa3);
#undef PK4
        if (VAR != 3 && t + 1 < NT) ATT_WRITE(buf ^ 1);
        if (VAR == 4) { asm volatile("" :: "v"(pa0), "v"(pa1), "v"(pa2), "v"(pa3)); }
        else { const LAS char* vp = vp0 + buf * G::VBUF;
          s16x4 la[4], ha[4], lb[4], hb[4];
#define VLOAD(L, H, d0) do { _Pragma("unroll") for (int ks = 0; ks < 4; ++ks) { L[ks] = vtr(vp + (d0) * 512 + ks * 4096); H[ks] = vtr(vp + (d0) * 512 + ks * 4096 + 2048); } } while (0)
#define VF(L, H, k) (bf16x8){L[k][0], L[k][1], L[k][2], L[k][3], H[k][0], H[k][1], H[k][2], H[k][3]}
#define VMMA(L, H, d0) do { o[d0] = __builtin_amdgcn_mfma_f32_32x32x16_bf16(pa0, VF(L, H, 0), o[d0], 0, 0, 0); o[d0] = __builtin_amdgcn_mfma_f32_32x32x16_bf16(pa1, VF(L, H, 1), o[d0], 0, 0, 0); \
              o[d0] = __builtin_amdgcn_mfma_f32_32x32x16_bf16(pa2, VF(L, H, 2), o[d0], 0, 0, 0); o[d0] = __builtin_amdgcn_mfma_f32_32x32x16_bf16(pa3, VF(L, H, 3), o[d0], 0, 0, 0); } while (0)
          VLOAD(la, ha, 0);
#pragma unroll
          for (int d0 = 0; d0 < ND0; d0 += 2) {
              if (d0 + 1 < ND0) VLOAD(lb, hb, d0 + 1);
              VMMA(la, ha, d0);
              if (d0 + 2 < ND0) VLOAD(la, ha, d0 + 2);
              if (d0 + 1 < ND0) VMMA(lb, hb, d0 + 1);
          }
#undef VLOAD
#undef VF
#undef VMMA
        }
        __syncthreads();
    }
#undef ATT_LOAD
#undef ATT_WRITE
    if (hi == 0) wsf[32 + r32] = l_reg;
    float rli[16];
#pragma unroll
    for (int r = 0; r < 16; ++r) rli[r] = __builtin_amdgcn_rcpf(wsf[32 + crow(r, hi)]);
#pragma unroll
    for (int r = 0; r < 16; ++r) { const int orow = crow(r, hi);
#pragma unroll
        for (int d0 = 0; d0 < ND0; ++d0) { const float v = o[d0][r] * rli[r]; const float vn = __shfl_xor(v, 1);
            if ((r32 & 1) == 0) *(unsigned*)(ow + (size_t)orow * OP + d0 * 32 + r32) = cvt_pk_bf16(v, vn); } }
}
}

constexpr int NWAVES = 8;
constexpr size_t MiB = 1u << 20, KiB = 1u << 10;
constexpr size_t WS_CTL = 0, CTL_ZERO_BYTES = 64 * KiB;
constexpr size_t WS_META = 64 * KiB;
constexpr size_t WS_SSQ = 1 * MiB, WS_SSKV = WS_SSQ + 256 * KiB, WS_SS2 = WS_SSKV + 256 * KiB;
constexpr size_t WS_TOKE = WS_SS2 + 64 * KiB, WS_TOKPOS = WS_TOKE + 64 * KiB, WS_TOKCW = WS_TOKPOS + 128 * KiB, WS_TOKR = WS_TOKCW + 128 * KiB, WS_TOKSLOT = WS_TOKR + 64 * KiB;
constexpr size_t WS_RG = WS_TOKSLOT + 128 * KiB, WS_CWS = WS_RG + 256 * KiB, WS_WR = WS_CWS + 256 * KiB;
static_assert(WS_WR + 80 * KiB <= 4 * MiB, "small arrays");
constexpr size_t WS_ROPE = 4 * MiB;
constexpr size_t WS_WIN = 8 * MiB, WS_WG = 12 * MiB, WS_WUQ = 16 * MiB, WS_WUKV = 17 * MiB, WS_WOUT = 18 * MiB, WS_WEI = 20 * MiB, WS_WEO = 36 * MiB, WS_WPG = 44 * MiB, WS_WPP = 46 * MiB;
constexpr size_t WS_XN = 48 * MiB, WS_PB = 80 * MiB, WS_PP = 88 * MiB, WS_QA = 120 * MiB, WS_KVA = 152 * MiB, WS_CQ = 160 * MiB, WS_CKV = 168 * MiB, WS_KR = 172 * MiB,
                 WS_Q = 174 * MiB, WS_MG = 222 * MiB, WS_XG = 120 * MiB, WS_ACT = 192 * MiB, WS_Y = 120 * MiB, WS_HB = 48 * MiB, WS_END = 256 * MiB;
static_assert(WS_Q + (size_t)T_TOK * QW * 2 <= WS_MG && WS_MG + (size_t)T_TOK * DM * 2 <= WS_END && WS_XG + (size_t)MAXSLOTS * DM * 2 <= WS_ACT && WS_ACT + (size_t)MAXSLOTS * DEXP * 2 <= WS_MG, "d_ws map");
constexpr int CW_BAR = 1024, CW_CNT = 8192;
constexpr int RING_BYTES = 131072, LDSCTL_OFF = RING_BYTES, MISC_OFF = LDSCTL_OFF + 320, LDS_BYTES = 147456;

typedef GAS unsigned gu32;
#define RLX_AGENT __ATOMIC_RELAXED, __HIP_MEMORY_SCOPE_AGENT
#define LDS_WAIT() asm volatile("s_waitcnt lgkmcnt(0)" ::: "memory")

#define XB_TMO      128
#define XB_XCNT(j)  (256  + 64 * (j))
#define XB_XSUB(j)  (1280 + 64 * (j))
#define XB_XGEN(j)  (2304 + 64 * (j))
#define XB_TOP      3328
#define XB_TOPGEN   3392
#define XCD_BAR_WORDS 3456
#define XB_SPIN_CAP (1u << 18)
__device__ __forceinline__ unsigned xb_ld(unsigned* p)              { return __hip_atomic_load(p, __ATOMIC_RELAXED, __HIP_MEMORY_SCOPE_AGENT); }
__device__ __forceinline__ unsigned xb_add(unsigned* p, unsigned v) { return __hip_atomic_fetch_add(p, v, __ATOMIC_RELAXED, __HIP_MEMORY_SCOPE_AGENT); }
__device__ __forceinline__ unsigned xb_xcc_id() { return (unsigned)__builtin_amdgcn_s_getreg((3 << 11) | 20) & 0xFu; }
#define XB_SPIN(cond, bar) do { unsigned _sp = 0; while (cond) { __builtin_amdgcn_s_sleep(1); \
    if ((++_sp & 255u) == 0u) { if (xb_ld(&(bar)[XB_TMO])) break; if (_sp > XB_SPIN_CAP) { atomicAdd(&(bar)[XB_TMO], 1u); break; } } } } while (0)
struct XcdBarrier { unsigned* bar; unsigned x; volatile LAS unsigned* st; };
__device__ __forceinline__ XcdBarrier xcd_barrier_post(unsigned* bar, volatile LAS unsigned* st) {
    XcdBarrier b; b.bar = bar; b.x = xb_xcc_id(); b.st = st;
    if (threadIdx.x == 0) (void)xb_add(&bar[XB_XCNT(b.x)], 1u);
    return b;
}
__device__ __forceinline__ void xcd_barrier_complete(unsigned* bar, unsigned x, unsigned& nloc, unsigned& nx) {
    const unsigned G = gridDim.x * gridDim.y * gridDim.z;
    unsigned sum, cnt, mine, sp = 0u;
    for (;;) {
        sum = 0u; cnt = 0u; mine = 0u;
#pragma unroll
        for (unsigned j = 0; j < 16; ++j) { const unsigned c = xb_ld(&bar[XB_XCNT(j)]); sum += c; cnt += (c > 0u) ? 1u : 0u; mine = (j == x) ? c : mine; }
        if (sum == G) break;
        __builtin_amdgcn_s_sleep(1);
        if ((++sp & 255u) == 0u) { if (xb_ld(&bar[XB_TMO])) break; if (sp > XB_SPIN_CAP) { atomicAdd(&bar[XB_TMO], 1u); break; } }
    }
    nloc = mine > 0u ? mine : 1u; nx = cnt > 0u ? cnt : 1u;
}
__device__ __forceinline__ void xcd_barrier(const XcdBarrier& b) {
    asm volatile("s_waitcnt vmcnt(0)" ::: "memory");
    __syncthreads();
    if (threadIdx.x == 0) {
        unsigned* bar = b.bar;
        __builtin_amdgcn_s_waitcnt(0);
        unsigned nloc = b.st[0], nx = b.st[1];
        if (nloc == 0u) { xcd_barrier_complete(bar, b.x, nloc, nx); b.st[0] = nloc; b.st[1] = nx; }
        const unsigned old = xb_add(&bar[XB_XSUB(b.x)], 1u);
        const unsigned gen = old / nloc;
        if (old + 1u == (gen + 1u) * nloc) {
            __builtin_amdgcn_fence(__ATOMIC_RELEASE, "agent");
            asm volatile("s_waitcnt vmcnt(0)" ::: "memory");
            const unsigned og = xb_add(&bar[XB_TOP], 1u);
            const unsigned tg = og / nx;
            if (og + 1u == (tg + 1u) * nx) xb_add(&bar[XB_TOPGEN], 1u);
            else XB_SPIN(xb_ld(&bar[XB_TOPGEN]) == tg, bar);
            __builtin_amdgcn_fence(__ATOMIC_ACQUIRE, "agent");
            xb_add(&bar[XB_XGEN(b.x)], 1u);
            asm volatile("s_waitcnt vmcnt(0)" ::: "memory");
        } else {
            XB_SPIN(xb_ld(&bar[XB_XGEN(b.x)]) == gen, bar);
            __builtin_amdgcn_fence(__ATOMIC_ACQUIRE, "agent");
            asm volatile("s_waitcnt vmcnt(0)" ::: "memory");
        }
    }
    __syncthreads();
}

__device__ __forceinline__ int pairdst(int j) { return j < 32 ? 2 * j : 2 * (j - 32) + 1; }
__device__ __forceinline__ int dst_row(int mat, int s) {
    switch (mat) {
    case 0:
        if (s < 1152) return (s & ~63) + pairdst(s & 63); if (s < 1664) return s; if (s < 1728) return 1664 + pairdst(s - 1664);
        if (s < 2752) { const int g = s - 1728; return 2048 + 256 * (g >> 7) + (g & 127); } { const int g = s - 2752; return 2048 + 256 * (g >> 7) + 128 + (g & 127); }
    case 2: { const int h = s / 192, j = s - h * 192; return j < 128 ? 128 * h + j : 1024 + 64 * h + pairdst(j - 128); }
    case 4: if (s < 256) return (s >> 7) * 256 + (s & 127); else { const int t = s - 256; return (t >> 7) * 256 + 128 + (t & 127); }
    default: return s;
    }
}
__device__ __forceinline__ void transpose_item(const float* W, int ldw, int K, int nsb, const float* gain, int mat, bf16_t* WT, LAS float* scr, int item, int lane) {
    const int kb = item / nsb, sb = item - kb * nsb, k0 = 64 * kb, s0 = 32 * sb;
    const int krow = lane >> 3, c4 = (lane & 7) * 4;
    f32x4 v[8];
#pragma unroll
    for (int i = 0; i < 8; ++i) v[i] = *(const f32x4*)(W + (size_t)(k0 + 8 * i + krow) * ldw + s0 + c4);
#pragma unroll
    for (int i = 0; i < 8; ++i) { const int kk = 8 * i + krow; const float gg = gain ? gain[k0 + kk] : 1.f; LAS float* d = scr + kk * 33 + c4;
        d[0] = v[i][0] * gg; d[1] = v[i][1] * gg; d[2] = v[i][2] * gg; d[3] = v[i][3] * gg; }
    LDS_WAIT(); asm volatile("" ::: "memory");
    const int c = lane & 7;
#pragma unroll
    for (int j = 0; j < 4; ++j) { const int n = (lane >> 3) + 8 * j; const LAS float* sp = scr + (8 * c) * 33 + n;
        u32x4 o; o.x = cvt_pk_bf16(sp[0 * 33], sp[1 * 33]); o.y = cvt_pk_bf16(sp[2 * 33], sp[3 * 33]); o.z = cvt_pk_bf16(sp[4 * 33], sp[5 * 33]); o.w = cvt_pk_bf16(sp[6 * 33], sp[7 * 33]);
        *(u32x4*)(WT + (size_t)dst_row(mat, s0 + n) * K + k0 + 8 * c) = o; }
    LDS_WAIT(); asm volatile("" ::: "memory");
}
__device__ __forceinline__ void sincos_d(float ang, float& c, float& s) {
    const double x = (double)ang, q = __builtin_rint(x * 0.63661977236758134308);
    double r = __builtin_fma(-q, 1.5707963267948966, x); r = __builtin_fma(-q, 6.123233995736766e-17, r);
    const double r2 = r * r;
    double sp = -1.0 / 1307674368000.0; sp = sp * r2 + 1.0 / 6227020800.0; sp = sp * r2 - 1.0 / 39916800.0; sp = sp * r2 + 1.0 / 362880.0; sp = sp * r2 - 1.0 / 5040.0; sp = sp * r2 + 1.0 / 120.0; sp = sp * r2 - 1.0 / 6.0; sp = sp * r2 + 1.0;
    const double sr = sp * r;
    double cp = 1.0 / 20922789888000.0; cp = cp * r2 - 1.0 / 87178291200.0; cp = cp * r2 + 1.0 / 479001600.0; cp = cp * r2 - 1.0 / 3628800.0; cp = cp * r2 + 1.0 / 40320.0; cp = cp * r2 - 1.0 / 720.0; cp = cp * r2 + 1.0 / 24.0; cp = cp * r2 - 0.5; cp = cp * r2 + 1.0;
    const int n = ((int)q) & 3;
    const double cc = (n == 0) ? cp : (n == 1) ? -sr : (n == 2) ? -cp : sr;
    const double ss = (n == 0) ? sr : (n == 1) ? cp : (n == 2) ? -sr : -cp;
    c = (float)cc; s = (float)ss;
}

typedef const __attribute__((address_space(4))) char* kptr_t;
__device__ __forceinline__ kptr_t kargp() { kptr_t p = (kptr_t)__builtin_amdgcn_kernarg_segment_ptr(); asm volatile("" : "+s"(p)); return p; }
template <class T> __device__ __forceinline__ T karg(kptr_t kp, int off) { return *(const __attribute__((address_space(4))) T*)(kp + off); }
#define KP_INIT kptr_t kp_ = kargp(); unsigned char* ws = karg<unsigned char*>(kp_, 176); (void)ws;
#define INP(i) karg<const float*>(kp_, 8 * (i))
#define OUTP karg<float*>(kp_, 168)
#define WSP(T, off) ((T*)(ws + (off)))
struct Args { const float* in[21]; float* out; unsigned char* ws; int ph_lo, ph_hi; };
constexpr int NPHASE = 13;

__global__ void __launch_bounds__(NWAVES * 64, 2) mk_fwd(Args) {
    extern __shared__ __attribute__((aligned(16))) unsigned char lds_raw[];
    LAS unsigned char* lds = (LAS unsigned char*)lds_raw;
    volatile LAS unsigned* MISC = (volatile LAS unsigned*)(lds + MISC_OFF);
    const int G = gridDim.x, bx = blockIdx.x, vcu = (G % 8 == 0) ? (bx % 8) * (G / 8) + bx / 8 : bx;
    const int NGW = G * NWAVES;
#define PH_IDS const int tid = opaque_tid(), lane = tid & 63, wave = __builtin_amdgcn_readfirstlane(tid >> 6), gw = vcu * NWAVES + wave; (void)lane; (void)gw;
    gu32* ctl; { KP_INIT ctl = (gu32*)(ws + WS_CTL); }
    { PH_IDS for (int u = tid; u < (LDS_BYTES - LDSCTL_OFF) / 4; u += NWAVES * 64) ((LAS unsigned*)(lds + LDSCTL_OFF))[u] = 0u; }
    __syncthreads();
    XcdBarrier bar; bar.bar = (unsigned*)(ctl + CW_BAR); bar.x = 0; bar.st = nullptr;
#if MK_ONE_LAUNCH
    bar = xcd_barrier_post((unsigned*)(ctl + CW_BAR), MISC + 8);
#define GRID_BAR() xcd_barrier(bar)
#else
#define GRID_BAR() do {} while (0)
#endif
    int lo, hi_ph; { KP_INIT lo = karg<int>(kp_, 184); hi_ph = karg<int>(kp_, 188); }
#ifndef PH_MASK
#define PH_MASK 0x1fff
#endif
#define IN(k) ((((PH_MASK) >> (k)) & 1) && lo <= (k) && (k) < hi_ph)
    unsigned long long t_p0 = 0, t_p1 = 0;
#define SEAM(k) do { if (IN(k) && IN((k) + 1)) GRID_BAR(); if ((k) == PROBE_HI) t_p1 = __builtin_amdgcn_s_memrealtime(); if ((k) + 1 == PROBE_LO) t_p0 = __builtin_amdgcn_s_memrealtime(); } while (0)

    if (PROBE_LO == 0) t_p0 = __builtin_amdgcn_s_memrealtime();
    if (IN(0)) { PH_IDS
        KP_INIT const float* x = INP(0); const float* p_in = INP(1); const float* g_mix = INP(2); const float* w_in = INP(3); const float* g_q = INP(5); const float* w_uq = INP(6); const float* g_kv = INP(7); const float* w_ukv = INP(8); const float* w_out = INP(9);
        const float* g_ffn = INP(10); const float* w_rg = INP(11); const float* w_re = INP(13); const float* w_ei = INP(15); const float* w_eo = INP(16); const float* g_ple = INP(17); const float* w_pg = INP(18); const float* w_pp = INP(19);
        bf16_t* Win_t = WSP(bf16_t, WS_WIN); bf16_t* Wg_t = WSP(bf16_t, WS_WG); bf16_t* Wuq_t = WSP(bf16_t, WS_WUQ); bf16_t* Wukv_t = WSP(bf16_t, WS_WUKV); bf16_t* Wout_t = WSP(bf16_t, WS_WOUT); bf16_t* Wei_t = WSP(bf16_t, WS_WEI);
        bf16_t* Weo_t = WSP(bf16_t, WS_WEO); bf16_t* Wpg_t = WSP(bf16_t, WS_WPG); bf16_t* Wpp_t = WSP(bf16_t, WS_WPP); bf16_t* XN = WSP(bf16_t, WS_XN); bf16_t* PB = WSP(bf16_t, WS_PB); float* WR = WSP(float, WS_WR); float* ROPE = WSP(float, WS_ROPE);
        LAS float* scr = (LAS float*)(lds + wave * 16384);
        constexpr int I_IN = 16 * 118, I_UQ = 4 * 48, I_UKV = 2 * 64, I_OUT = 16 * 32, I_EI1 = 16 * 16, I_EI = NEXP * I_EI1, I_EO1 = 4 * 32, I_EO = NEXP * I_EO1, I_PG = 16 * 32, I_PP = 4 * 32;
        constexpr int NITEMS = I_IN + I_UQ + I_UKV + I_OUT + I_EI + I_EO + I_PG + I_PP;
        (void)Wg_t;
        static_assert(WS_WG - WS_WIN == 2048 * 1024 * 2, "gate weights sit 2048 rows above Win_t");
        for (int it = gw; it < NITEMS; it += NGW) {
            int r = it;
            if (r < I_IN) { transpose_item(w_in, 3776, 1024, 118, nullptr, 0, Win_t, scr, r, lane); continue; } r -= I_IN;
            if (r < I_UQ) { transpose_item(w_uq, QW, 256, 48, g_q, 2, Wuq_t, scr, r, lane); continue; } r -= I_UQ;
            if (r < I_UKV) { transpose_item(w_ukv, KVW, 128, 64, g_kv, 3, Wukv_t, scr, r, lane); continue; } r -= I_UKV;
            if (r < I_OUT) { transpose_item(w_out, 1024, 1024, 32, nullptr, 3, Wout_t, scr, r, lane); continue; } r -= I_OUT;
            if (r < I_EI) { const int e = r / I_EI1; transpose_item(w_ei + (size_t)e * 1024 * 512, 512, 1024, 16, g_ffn, 4, Wei_t + (size_t)e * 512 * 1024, scr, r % I_EI1, lane); continue; } r -= I_EI;
            if (r < I_EO) { const int e = r / I_EO1; transpose_item(w_eo + (size_t)e * 256 * 1024, 1024, 256, 32, nullptr, 3, Weo_t + (size_t)e * 1024 * 256, scr, r % I_EO1, lane); continue; } r -= I_EO;
            if (r < I_PG) { transpose_item(w_pg, 1024, 1024, 32, g_ple, 3, Wpg_t, scr, r, lane); continue; } r -= I_PG;
            transpose_item(w_pp, 1024, 256, 32, nullptr, 3, Wpp_t, scr, r, lane);
        }
        for (int e = bx * (NWAVES * 64) + tid; e < 64 * 1024 / 8; e += G * NWAVES * 64) *((u32x4*)(Win_t + (size_t)1728 * 1024) + e) = (u32x4){0u, 0u, 0u, 0u};
        { f32x4 gg[4];
#pragma unroll
          for (int j = 0; j < 4; ++j) gg[j] = *((const f32x4*)g_mix + lane + 64 * j);
          for (int m0 = gw; m0 < T_TOK; m0 += 2 * NGW) {
            f32x4 v[2][4], pv[2];
#pragma unroll
            for (int q = 0; q < 2; ++q) { const int m = m0 + q * NGW < T_TOK ? m0 + q * NGW : m0; const f32x4* xr = (const f32x4*)(x + (size_t)m * DM) + lane;
#pragma unroll
                for (int j = 0; j < 4; ++j) v[q][j] = xr[64 * j];
                pv[q] = *((const f32x4*)(p_in + (size_t)m * 256) + lane); }
#pragma unroll
            for (int q = 0; q < 2; ++q) { const int m = m0 + q * NGW; if (m >= T_TOK) break; float s = 0.f;
#pragma unroll
                for (int j = 0; j < 4; ++j) s += (v[q][j].x * v[q][j].x + v[q][j].y * v[q][j].y) + (v[q][j].z * v[q][j].z + v[q][j].w * v[q][j].w);
                const float rs = __builtin_amdgcn_rsqf(wave_sum(s) * (1.f / DM) + EPS);
                u32x2* o8 = (u32x2*)(XN + (size_t)m * DM) + lane;
#pragma unroll
                for (int j = 0; j < 4; ++j) { u32x2 w; w.x = cvt_pk_bf16(v[q][j].x * rs * gg[j].x, v[q][j].y * rs * gg[j].y); w.y = cvt_pk_bf16(v[q][j].z * rs * gg[j].z, v[q][j].w * rs * gg[j].w); o8[64 * j] = w; }
                u32x2 w; w.x = cvt_pk_bf16(pv[q].x, pv[q].y); w.y = cvt_pk_bf16(pv[q].z, pv[q].w);
                *((u32x2*)(PB + (size_t)m * 256) + lane) = w; }
          } }
        for (int e = bx * (NWAVES * 64) + tid; e < SEQ * 32; e += G * NWAVES * 64) {
            const int pos = e >> 5, i = e & 31; const float inv = powf(10000.f, -(float)(2 * i) / 64.f); const float ang = (float)pos * inv;
            float c, s; sincos_d(ang, c, s); *(f32x2*)(ROPE + (size_t)e * 2) = (f32x2){c, s};
        }
        for (int e = bx * (NWAVES * 64) + tid; e < 20 * 1024; e += G * NWAVES * 64) {
            const int j = e >> 10, k = e & 1023; WR[e] = g_ffn[k] * (j < 4 ? w_rg[k * 4 + j] : w_re[k * 16 + (j - 4)]);
        }
    }
    SEAM(0);
    if (IN(1)) {
        KP_INIT bf16_t* XN = WSP(bf16_t, WS_XN); bf16_t* Win_t = WSP(bf16_t, WS_WIN); bf16_t* PB = WSP(bf16_t, WS_PB); bf16_t* Wpp_t = WSP(bf16_t, WS_WPP); bf16_t* PP = WSP(bf16_t, WS_PP); bf16_t* QA = WSP(bf16_t, WS_QA); bf16_t* KVA = WSP(bf16_t, WS_KVA);
        bf16_t* CQ = WSP(bf16_t, WS_CQ); bf16_t* CKV = WSP(bf16_t, WS_CKV); bf16_t* KR = WSP(bf16_t, WS_KR); float* SSQ = WSP(float, WS_SSQ); float* SSKV = WSP(float, WS_SSKV); float* ROPE = WSP(float, WS_ROPE);
        { pg8::Gemm g{XN, Win_t, 1024}; pg8::StaticOrder S; S.init(T_TOK, N1, G, bx);
          pg8::EpiIn E{QA, KVA, CQ, CKV, KR, SSQ, SSKV, ROPE}; pg8::gemm_phase(lds, g, S, E); }
        if (bx >= G - 64) { pg8::Gemm g{PB, Wpp_t, 256}; pg8::StaticOrder S; S.init(T_TOK, 1024, 64, bx - (G - 64));
          pg8::EpiRows E{PP, DM, nullptr, 0.f, 1.f, 1 << 30, nullptr}; pg8::gemm_phase(lds, g, S, E); }
    }
    SEAM(1);
    if (IN(2)) { PH_IDS
        KP_INIT const float* sinks = INP(4); bf16_t* CQ = WSP(bf16_t, WS_CQ); bf16_t* CKV = WSP(bf16_t, WS_CKV); bf16_t* Wuq_t = WSP(bf16_t, WS_WUQ); bf16_t* Wukv_t = WSP(bf16_t, WS_WUKV); bf16_t* Qm = WSP(bf16_t, WS_Q); bf16_t* KVm = (bf16_t*)OUTP;
        bf16_t* QA = WSP(bf16_t, WS_QA); bf16_t* KVA = WSP(bf16_t, WS_KVA); float* SSQ = WSP(float, WS_SSQ); float* SSKV = WSP(float, WS_SSKV); float* ROPE = WSP(float, WS_ROPE);
        { pg8::Gemm g{CQ, Wuq_t, 256}; pg8::StaticOrder S; S.init(T_TOK, QW, G, bx);
          pg8::EpiRows E{Qm, QW, SSQ, 1.f / 256.f, C2MLA, 4, ROPE}; pg8::gemm_phase(lds, g, S, E); }
        { pg8::Gemm g{CKV, Wukv_t, 128}; pg8::StaticOrder S; S.init(T_TOK, KVW, G, bx);
          pg8::EpiRows E{KVm, KVW, SSKV, 1.f / 128.f, 1.f, 1 << 30, nullptr}; pg8::gemm_phase(lds, g, S, E); }
        for (int uidx = vcu; uidx < 2 * 2 * 256; uidx += G) {
            const int pblk = uidx & 255, kvh = (uidx >> 8) & 1, b = uidx >> 9;
            const int h = kvh * 8 + wave, pos0 = pblk * 32; const size_t rowb = (size_t)b * SEQ;
            const int lowk = pos0 - 127; const int j_lo = lowk > 0 ? lowk / 64 : 0, j_hi = (pos0 + 31) / 64 + 1;
            const bf16_t* qp = QA + (rowb + pos0) * DM + h * 64;
            att::attn_unit<64, 64, 64>((LAS char*)lds, qp, qp, DM, KVA + rowb * 256 + kvh * 64, 256, nullptr, 0, KVA + rowb * 256 + 128 + kvh * 64, 256,
                                       j_lo, j_hi, pos0, 128u, sinks[h] * LOG2E, 1.f, QA + (rowb + pos0) * DM + h * 64, DM);
        }
    }
    SEAM(2);
#if PROBE_ATT >= 0
    {   PH_IDS KP_INIT bf16_t* Qm = WSP(bf16_t, WS_Q); bf16_t* KVm = (bf16_t*)OUTP; bf16_t* KR = WSP(bf16_t, WS_KR); bf16_t* MG = WSP(bf16_t, WS_MG);
        t_p0 = __builtin_amdgcn_s_memrealtime();
        for (int pi = vcu; pi < 256; pi += G) {
            const int bh = pi >> 4, s = pi & 15, b = bh >> 3, h = bh & 7; const size_t rowb = (size_t)b * SEQ;
            for (int pass = 0; pass < 2; ++pass) {
                const int qb = pass == 0 ? 31 - s : s, q0 = qb * 256 + wave * 32;
                const bf16_t* q1 = Qm + (rowb + q0) * QW + h * 128; const bf16_t* q2 = Qm + (rowb + q0) * QW + 1024 + h * 64;
                att::attn_unit<192, 128, 128, PROBE_ATT>((LAS char*)lds, q1, q2, QW, KVm + rowb * KVW + h * 256, KVW, KR + rowb * 64, 64, KVm + rowb * KVW + h * 256 + 128, KVW,
                                              0, (qb + 1) * 4, q0, 1u << 30, -1e30f, 0.f, MG + (rowb + q0) * DM + h * 128, DM);
            }
        }
        GRID_BAR(); t_p1 = __builtin_amdgcn_s_memrealtime();
    }
#endif
    if (IN(3)) { PH_IDS
        KP_INIT bf16_t* Qm = WSP(bf16_t, WS_Q); bf16_t* KVm = (bf16_t*)OUTP; bf16_t* KR = WSP(bf16_t, WS_KR);
        for (int pi = vcu; pi < 256; pi += G) {
            const int bh = pi >> 4, s = pi & 15, b = bh >> 3, h = bh & 7; const size_t rowb = (size_t)b * SEQ;
            for (int pass = 0; pass < 2; ++pass) {
                const int qb = pass == 0 ? 31 - s : s, q0 = qb * 256 + wave * 32;
                const bf16_t* q1 = Qm + (rowb + q0) * QW + h * 128; const bf16_t* q2 = Qm + (rowb + q0) * QW + 1024 + h * 64;
                att::attn_unit<192, 128, 128>((LAS char*)lds, q1, q2, QW, KVm + rowb * KVW + h * 256, KVW, KR + rowb * 64, 64, KVm + rowb * KVW + h * 256 + 128, KVW,
                                              0, (qb + 1) * 4, q0, 1u << 30, -1e30f, 0.f, Qm + (rowb + q0) * QW + h * 128, QW);
            }
        }
    }
    SEAM(3);
    if (IN(4)) {
        KP_INIT bf16_t* XN = WSP(bf16_t, WS_XN); bf16_t* Wg_t = WSP(bf16_t, WS_WG); bf16_t* QA = WSP(bf16_t, WS_QA); bf16_t* Qm = WSP(bf16_t, WS_Q); bf16_t* MG = WSP(bf16_t, WS_MG);
        pg8::Gemm g{XN, Wg_t, 1024}; pg8::StaticOrder S; S.init(T_TOK, NGATE, G, bx);
        pg8::EpiGate E{QA, Qm, QW, MG}; pg8::gemm_phase(lds, g, S, E);
    }
    SEAM(4);
    if (IN(5)) {
        KP_INIT const float* x = INP(0); float* out = OUTP; bf16_t* MG = WSP(bf16_t, WS_MG); bf16_t* Wout_t = WSP(bf16_t, WS_WOUT); bf16_t* HB = WSP(bf16_t, WS_HB);
        pg8::Gemm g{MG, Wout_t, 1024}; pg8::StaticOrder S; S.init(T_TOK, 1024, G, bx);
        pg8::EpiRes E{x, out, HB}; pg8::gemm_phase(lds, g, S, E);
    }
    SEAM(5);
    if (IN(6)) { PH_IDS
        KP_INIT const float* b_rg = INP(12); const float* b_re = INP(14); float* out = OUTP; float* WR = WSP(float, WS_WR); int* TOKE = WSP(int, WS_TOKE); int* TOKPOS = WSP(int, WS_TOKPOS); float* TOKCW = WSP(float, WS_TOKCW); float* TOKR = WSP(float, WS_TOKR);
        LAS float* wl = (LAS float*)lds;
        for (int i = tid; i < 20 * 256; i += NWAVES * 64) ((LAS f32x4*)wl)[i] = ((const f32x4*)WR)[i];
        __syncthreads();
        for (int m = gw; m < T_TOK; m += NGW) {
            const f32x4* hr = (const f32x4*)(out + (size_t)m * DM) + lane; f32x4 v[4]; float s = 0.f;
#pragma unroll
            for (int j = 0; j < 4; ++j) { v[j] = hr[64 * j]; s += (v[j].x * v[j].x + v[j].y * v[j].y) + (v[j].z * v[j].z + v[j].w * v[j].w); }
            const float r2 = __builtin_amdgcn_rsqf(wave_sum(s) * (1.f / DM) + EPS);
            float lg[20];
#pragma unroll
            for (int c = 0; c < 20; ++c) { float d = 0.f;
#pragma unroll
                for (int j = 0; j < 4; ++j) { const f32x4 w = ((const LAS f32x4*)wl)[c * 256 + 64 * j + lane]; d += (v[j].x * w.x + v[j].y * w.y) + (v[j].z * w.z + v[j].w * w.w); }
                lg[c] = wave_sum(d) * r2; asm volatile("" ::: "memory"); }
#pragma unroll
            for (int c = 0; c < 4; ++c) lg[c] += b_rg[c];
#pragma unroll
            for (int c = 0; c < 16; ++c) lg[4 + c] += b_re[c];
            int gi = 0; float gm = lg[0];
#pragma unroll
            for (int c = 1; c < 4; ++c) if (lg[c] > gm) { gm = lg[c]; gi = c; }
            float gs = 0.f;
#pragma unroll
            for (int c = 0; c < 4; ++c) gs += __expf(lg[c] - gm);
            const float g_w = 1.f / gs;
            float es[4];
#pragma unroll
            for (int k = 0; k < 4; ++k) es[k] = gi == 0 ? lg[4 + k] : gi == 1 ? lg[8 + k] : gi == 2 ? lg[12 + k] : lg[16 + k];
            int i0 = 0; float e0 = es[0];
#pragma unroll
            for (int k = 1; k < 4; ++k) if (es[k] > e0) { e0 = es[k]; i0 = k; }
            int i1 = -1; float e1 = -__builtin_inff();
#pragma unroll
            for (int k = 0; k < 4; ++k) if (k != i0 && es[k] > e1) { e1 = es[k]; i1 = k; }
            const float t1 = __expf(e1 - e0), w0 = 1.f / (1.f + t1), w1 = t1 * w0;
            if (lane == 0) {
                const int ex0 = gi * 4 + i0, ex1 = gi * 4 + i1;
                const int p0 = (int)__hip_atomic_fetch_add(ctl + CW_CNT + 64 * ex0, 1u, RLX_AGENT), p1 = (int)__hip_atomic_fetch_add(ctl + CW_CNT + 64 * ex1, 1u, RLX_AGENT);
                TOKE[m] = ex0 | (ex1 << 8); TOKPOS[2 * m] = p0; TOKPOS[2 * m + 1] = p1; TOKCW[2 * m] = w0 * g_w; TOKCW[2 * m + 1] = w1 * g_w; TOKR[m] = r2;
            }
        }
    }
    SEAM(6);
    if (IN(7)) { PH_IDS
        KP_INIT bf16_t* HB = WSP(bf16_t, WS_HB); bf16_t* XG = WSP(bf16_t, WS_XG); int* TOKE = WSP(int, WS_TOKE); int* TOKPOS = WSP(int, WS_TOKPOS); float* TOKCW = WSP(float, WS_TOKCW); float* TOKR = WSP(float, WS_TOKR); int* TOKSLOT = WSP(int, WS_TOKSLOT);
        float* RG = WSP(float, WS_RG); float* CWS = WSP(float, WS_CWS); int* META = WSP(int, WS_META);
        int off[NEXP]; int tot = 0;
#pragma unroll
        for (int e = 0; e < NEXP; ++e) { const int c = (int)__builtin_amdgcn_readfirstlane(__hip_atomic_load(ctl + CW_CNT + 64 * e, RLX_AGENT)); off[e] = tot; tot += (c + 255) >> 8; }
        if (bx == 0) { if (tid == 0) META[0] = tot;
            if (tid < MAXTILES) { int ee = 0;
#pragma unroll
                for (int e = 1; e < NEXP; ++e) if (tid >= off[e]) ee = e;
                META[16 + tid] = ee; } }
        for (int m = gw; m < T_TOK; m += NGW) {
            const int ee = TOKE[m], ex0 = ee & 255, ex1 = ee >> 8; int o0 = 0, o1 = 0;
#pragma unroll
            for (int e = 0; e < NEXP; ++e) { o0 = (e == ex0) ? off[e] : o0; o1 = (e == ex1) ? off[e] : o1; }
            const int s0 = o0 * 256 + TOKPOS[2 * m], s1 = o1 * 256 + TOKPOS[2 * m + 1];
            const u32x4* src = (const u32x4*)(HB + (size_t)m * DM) + lane; const u32x4 a = src[0], b2 = src[64];
            u32x4* d0 = (u32x4*)(XG + (size_t)s0 * DM) + lane; u32x4* d1 = (u32x4*)(XG + (size_t)s1 * DM) + lane;
            d0[0] = a; d0[64] = b2; d1[0] = a; d1[64] = b2;
            if (lane == 0) { const float r2 = TOKR[m]; RG[s0] = r2; RG[s1] = r2; CWS[s0] = TOKCW[2 * m]; CWS[s1] = TOKCW[2 * m + 1]; TOKSLOT[2 * m] = s0; TOKSLOT[2 * m + 1] = s1; }
        }
    }
    SEAM(7);
    if (IN(8)) {
        KP_INIT bf16_t* XG = WSP(bf16_t, WS_XG); bf16_t* Wei_t = WSP(bf16_t, WS_WEI); bf16_t* ACT = WSP(bf16_t, WS_ACT); float* RG = WSP(float, WS_RG); float* CWS = WSP(float, WS_CWS); int* META = WSP(int, WS_META);
        pg8::Gemm g{XG, Wei_t, 1024}; pg8::GroupedOrder S; S.init(META, 2, G, bx);
        pg8::EpiMoeIn E{RG, CWS, ACT}; pg8::gemm_phase(lds, g, S, E);
    }
    SEAM(8);
    if (IN(9)) {
        KP_INIT bf16_t* ACT = WSP(bf16_t, WS_ACT); bf16_t* Weo_t = WSP(bf16_t, WS_WEO); bf16_t* Y = WSP(bf16_t, WS_Y); int* META = WSP(int, WS_META);
        pg8::Gemm g{ACT, Weo_t, 256}; pg8::GroupedOrder S; S.init(META, 4, G, bx);
        pg8::EpiRows E{Y, DM, nullptr, 0.f, 1.f, 1 << 30, nullptr}; pg8::gemm_phase(lds, g, S, E);
    }
    SEAM(9);
    if (IN(10)) { PH_IDS
        KP_INIT float* out = OUTP; bf16_t* Y = WSP(bf16_t, WS_Y); bf16_t* HB = WSP(bf16_t, WS_HB); int* TOKSLOT = WSP(int, WS_TOKSLOT); float* SS2 = WSP(float, WS_SS2);
        for (int m = gw; m < T_TOK; m += NGW) {
            const int s0 = TOKSLOT[2 * m], s1 = TOKSLOT[2 * m + 1];
            f32x4* hr = (f32x4*)(out + (size_t)m * DM) + lane; const u32x2* y0 = (const u32x2*)(Y + (size_t)s0 * DM) + lane; const u32x2* y1 = (const u32x2*)(Y + (size_t)s1 * DM) + lane;
            u32x2* hb = (u32x2*)(HB + (size_t)m * DM) + lane; float s = 0.f;
#pragma unroll
            for (int j = 0; j < 4; ++j) { f32x4 v = hr[64 * j]; const u32x2 a = y0[64 * j], b2 = y1[64 * j];
                v.x += bf_lo(a.x) + bf_lo(b2.x); v.y += bf_hi(a.x) + bf_hi(b2.x); v.z += bf_lo(a.y) + bf_lo(b2.y); v.w += bf_hi(a.y) + bf_hi(b2.y);
                s += (v.x * v.x + v.y * v.y) + (v.z * v.z + v.w * v.w); hr[64 * j] = v;
                u32x2 w; w.x = cvt_pk_bf16(v.x, v.y); w.y = cvt_pk_bf16(v.z, v.w); hb[64 * j] = w; }
            s = wave_sum(s); if (lane == 0) SS2[m] = s;
        }
    }
    SEAM(10);
    if (IN(11)) {
        KP_INIT float* out = OUTP; bf16_t* HB = WSP(bf16_t, WS_HB); bf16_t* Wpg_t = WSP(bf16_t, WS_WPG); bf16_t* PP = WSP(bf16_t, WS_PP); float* SS2 = WSP(float, WS_SS2);
        pg8::Gemm g{HB, Wpg_t, 1024}; pg8::StaticOrder S; S.init(T_TOK, 1024, G, bx);
        pg8::EpiPle E{out, PP, SS2}; pg8::gemm_phase(lds, g, S, E);
    }
    SEAM(11);
    if (IN(12)) { PH_IDS
        KP_INIT float* out = OUTP; const float* g_fin = INP(20);
        for (int m = gw; m < T_TOK; m += NGW) {
            f32x4* hr = (f32x4*)(out + (size_t)m * DM) + lane; f32x4 v[4]; float s = 0.f;
#pragma unroll
            for (int j = 0; j < 4; ++j) { v[j] = hr[64 * j]; s += (v[j].x * v[j].x + v[j].y * v[j].y) + (v[j].z * v[j].z + v[j].w * v[j].w); }
            const float rs = __builtin_amdgcn_rsqf(wave_sum(s) * (1.f / DM) + EPS);
#pragma unroll
            for (int j = 0; j < 4; ++j) { const f32x4 gg = *((const f32x4*)g_fin + lane + 64 * j); hr[64 * j] = (f32x4){v[j].x * rs * gg.x, v[j].y * rs * gg.y, v[j].z * rs * gg.z, v[j].w * rs * gg.w}; }
        }
    }
    if (PROBE_LO >= 0 || PROBE_ATT >= 0) { if (PROBE_HI == NPHASE - 1) t_p1 = __builtin_amdgcn_s_memrealtime();
        if (bx == 0) { const unsigned long long te = __builtin_amdgcn_s_memrealtime(), d = (t_p1 - t_p0) * PROBE_MUL; while (__builtin_amdgcn_s_memrealtime() - te < d) __builtin_amdgcn_s_sleep(8); } }
#undef IN
#undef SEAM
#undef GRID_BAR
}

extern "C" void kernel_launch(void* const* d_in, const int* in_sizes, int n_in, void* d_out, int out_size, void* d_ws, size_t ws_size, hipStream_t stream) {
    static int grid = 0;
    if (grid == 0) {
        if (n_in != 21 || in_sizes[0] != T_TOK * DM || out_size != T_TOK * DM || ws_size < WS_END) { fprintf(stderr, "kernel_launch: unexpected shapes (n_in %d, in0 %d, out %d, ws %zu)\n", n_in, n_in > 0 ? in_sizes[0] : -1, out_size, ws_size); grid = -1; return; }
        int dev = 0, cus = 0, per_cu = 0;
        if (hipGetDevice(&dev) != hipSuccess || hipDeviceGetAttribute(&cus, hipDeviceAttributeMultiprocessorCount, dev) != hipSuccess) { grid = -1; return; }
        if (hipFuncSetAttribute((const void*)mk_fwd, hipFuncAttributeMaxDynamicSharedMemorySize, LDS_BYTES) != hipSuccess) { fprintf(stderr, "kernel_launch: hipFuncSetAttribute failed\n"); grid = -1; return; }
        if (hipOccupancyMaxActiveBlocksPerMultiprocessor(&per_cu, (const void*)mk_fwd, NWAVES * 64, LDS_BYTES) != hipSuccess || per_cu < 1) { fprintf(stderr, "kernel_launch: occupancy query says %d blocks per CU\n", per_cu); (void)hipGetLastError(); grid = -1; return; }
        grid = cus;
    }
    if (grid < 0) return;
    (void)hipMemsetAsync((char*)d_ws + WS_CTL, 0, CTL_ZERO_BYTES, stream);
    Args a{};
    for (int i = 0; i < 21; ++i) a.in[i] = (const float*)d_in[i];
    a.out = (float*)d_out; a.ws = (unsigned char*)d_ws;
#if MK_ONE_LAUNCH
    a.ph_lo = 0; a.ph_hi = NPHASE;
    hipLaunchKernelGGL(mk_fwd, dim3(grid), dim3(NWAVES * 64), LDS_BYTES, stream, a);
#else
    for (int ph = 0; ph < NPHASE; ++ph) { a.ph_lo = ph; a.ph_hi = ph + 1; hipLaunchKernelGGL(mk_fwd, dim3(grid), dim3(NWAVES * 64), LDS_BYTES, stream, a); }
#endif
}
```

```cpp
#include <hip/hip_runtime.h>
#include <hip/hip_bf16.h>
#include <cstdio>
#include <cstdint>

#ifndef MK_ONE_LAUNCH
#define MK_ONE_LAUNCH 1
#endif

#ifndef PROBE_LO
#define PROBE_LO -1
#define PROBE_HI -1
#endif
#ifndef PROBE_MUL
#define PROBE_MUL 3
#endif
#ifndef PROBE_ATT
#define PROBE_ATT -1
#endif
#define LAS __attribute__((address_space(3)))
#define GAS __attribute__((address_space(1)))
typedef unsigned short bf16_t;
typedef short bf16x8 __attribute__((ext_vector_type(8)));
typedef short s16x4 __attribute__((ext_vector_type(4)));
typedef float f32x2 __attribute__((ext_vector_type(2)));
typedef float f32x4 __attribute__((ext_vector_type(4)));
typedef float f32x16 __attribute__((ext_vector_type(16)));
typedef unsigned u32x2 __attribute__((ext_vector_type(2)));
typedef unsigned u32x4 __attribute__((ext_vector_type(4)));

constexpr int T_TOK = 16384, SEQ = 8192, DM = 1024;
constexpr int N1 = 1792;
constexpr int NGATE = 2048;
constexpr int QW = 1536, KVW = 2048;
constexpr int NEXP = 16, DEXP = 256;
constexpr int MAXTILES = 144, MAXSLOTS = MAXTILES * 256;
constexpr float EPS = 1e-6f;
constexpr float LOG2E = 1.4426950408889634f;
constexpr float C2SWA = 0.125f * LOG2E;
constexpr float C2MLA = 0.07216878364870322f * LOG2E;

__device__ __forceinline__ unsigned cvt_pk_bf16(float lo, float hi) { unsigned r; asm volatile("v_cvt_pk_bf16_f32 %0, %1, %2" : "=v"(r) : "v"(lo), "v"(hi)); return r; }
__device__ __forceinline__ float bf_lo(unsigned w) { return __uint_as_float(w << 16); }
__device__ __forceinline__ float bf_hi(unsigned w) { return __uint_as_float(w & 0xffff0000u); }
__device__ __forceinline__ float fsigmoid(float x) { return __builtin_amdgcn_rcpf(1.f + __builtin_amdgcn_exp2f(-x * LOG2E)); }
__device__ __forceinline__ int opaque_tid() { int t = threadIdx.x; asm volatile("" : "+v"(t)); return t; }
__device__ __forceinline__ float dpp_add(float v, int ctrl_sel) {
    const int b = __builtin_bit_cast(int, v); int r;
    switch (ctrl_sel) { case 0: r = __builtin_amdgcn_update_dpp(0, b, 0xB1, 0xf, 0xf, true); break;
                        case 1: r = __builtin_amdgcn_update_dpp(0, b, 0x4E, 0xf, 0xf, true); break;
                        case 2: r = __builtin_amdgcn_update_dpp(0, b, 0x141, 0xf, 0xf, true); break;
                        default: r = __builtin_amdgcn_update_dpp(0, b, 0x140, 0xf, 0xf, true); break; }
    return v + __builtin_bit_cast(float, r);
}
__device__ __forceinline__ float wave_sum(float v) {
    v = dpp_add(v, 0); v = dpp_add(v, 1); v = dpp_add(v, 2); v = dpp_add(v, 3);
    { auto rr = __builtin_amdgcn_permlane16_swap(__float_as_uint(v), __float_as_uint(v), false, false); v = __uint_as_float(rr[0]) + __uint_as_float(rr[1]); }
    { auto rr = __builtin_amdgcn_permlane32_swap(__float_as_uint(v), __float_as_uint(v), false, false); v = __uint_as_float(rr[0]) + __uint_as_float(rr[1]); }
    return v;
}

namespace pg8 {
constexpr int BM = 256, BK = 64, HALF = 128, HTB = HALF * BK * 2, STAGE_BYTES = 8 * HTB, NXCD = 8, WGM = 8;
__host__ __device__ __forceinline__ int lds_byte(int r, int c) { const int st = (r >> 4) * 2 + (c >> 5), rr = r & 15, cc = c & 31, ob = rr * 64 + cc * 2; return st * 1024 + (ob ^ (((ob >> 9) & 1) << 5)); }
__host__ __device__ __forceinline__ void stage_rc(int b, int& R, int& C) { const int st = b / 1024, sb = b % 1024, swz = sb ^ (((sb >> 9) & 1) << 5); R = (st >> 1) * 16 + swz / 64; C = (st & 1) * 32 + (swz % 64) / 2; }
__host__ __device__ __forceinline__ int perm32(int rho) { const int n = rho >> 4, i = rho & 15; return 8 * (i >> 2) + 4 * n + (i & 3); }

struct Unit { int pm, pn, pb, e, lt, cnt; };
struct Gemm { const bf16_t* A; const bf16_t* Bt; int K; };

struct StaticOrder {
    int nM, nN, nwg, G, c;
    __device__ __forceinline__ void init(int M, int N, int G_, int c_) { nM = M / BM; nN = N / BM; nwg = nM * nN; G = G_; c = c_; }
    __device__ __forceinline__ bool next(int i, Unit& u) const {
        const long L = (long)i * G + c; if (L >= nwg) return false;
        int wgid = (int)L; { const int q = nwg / NXCD, r = nwg % NXCD, xcd = wgid % NXCD, off = wgid / NXCD; wgid = (xcd < r ? xcd * (q + 1) : r * (q + 1) + (xcd - r) * q) + off; }
        const int nig = WGM * nN, gid = wgid / nig, fm = gid * WGM, gsz = (nM - fm) < WGM ? (nM - fm) : WGM;
        u.pm = fm + ((wgid % nig) % gsz); u.pn = (wgid % nig) / gsz; u.pb = u.pn; u.e = 0; u.lt = 0; u.cnt = 0; return true;
    }
};
struct GroupedOrder {
    int cnt[NEXP]; int npn, G, c;
    __device__ __forceinline__ void init(const unsigned* cntw, int npn_, int G_, int c_) { npn = npn_; G = G_; c = c_;
        unsigned t[NEXP];
#pragma unroll
        for (int k = 0; k < NEXP; ++k) t[k] = __hip_atomic_load(cntw + 64 * k, __ATOMIC_RELAXED, __HIP_MEMORY_SCOPE_AGENT);
#pragma unroll
        for (int k = 0; k < NEXP; ++k) cnt[k] = (int)__builtin_amdgcn_readfirstlane(t[k]); }
    __device__ __forceinline__ bool next(int i, Unit& u) const {
        const int L = i * G + c, pm = L / npn; int acc = 0, e = -1, lt = 0, ce = 0;
#pragma unroll
        for (int k = 0; k < NEXP; ++k) { const int nt = (cnt[k] + 255) >> 8; if (pm >= acc && pm < acc + nt) { e = k; lt = pm - acc; ce = cnt[k]; } acc += nt; }
        if (e < 0) return false;
        u.pm = pm; u.pn = L - pm * npn; u.pb = e * npn + u.pn; u.e = e; u.lt = lt; u.cnt = ce; return true;
    }
};

typedef f32x4 Acc[2][2][4][2];

template <bool GATHER = false, class Epi, class Sched>
__device__ __forceinline__ void gemm_phase(LAS unsigned char* lds, const Gemm g, const Sched& S, const Epi& E, const int* vtok = nullptr) {
    const int tid = opaque_tid(), wid = __builtin_amdgcn_readfirstlane(tid >> 6), lane = tid & 63, wr = wid >> 2, wc = wid & 3, fr = lane & 15, fq = lane >> 4;
    const int K = g.K, nt = K / BK;
    unsigned voffA[2], voffB[2], gC[2]; int gR[2];
    unsigned voffc[2][2], voffn[2][2];
#pragma unroll
    for (int i = 0; i < 2; ++i) { int R, C; stage_rc(tid * 16 + i * 8192, R, C); const int Rb = (R & ~31) + perm32(R & 31);
        voffA[i] = (unsigned)(R * K + C) * 2u; voffB[i] = (unsigned)(Rb * K + C) * 2u; gR[i] = R; gC[i] = (unsigned)C * 2u; }
    const size_t kstep = (size_t)(BK * 2);
    const size_t hstep = (size_t)HALF * K * 2;
    const size_t tstep = 2 * hstep;
    const unsigned ldsw = (unsigned)wid * 1024u;
    const int aoff = lds_byte(wr * 64 + fr, fq * 8), boff = lds_byte(wc * 32 + fr, fq * 8);
#define PG8_SA(b, h) (((b) * 2 + (h)) * HTB)
#define PG8_SB(b, h) ((4 + (b) * 2 + (h)) * HTB)
#define PG8_STAGE(bufoff, gbase, voff) do { _Pragma("unroll") for (int _i = 0; _i < 2; ++_i) \
        __builtin_amdgcn_global_load_lds((const unsigned*)((const char*)(gbase) + (voff)[_i]), (LAS unsigned*)(lds + (bufoff) + ldsw + _i * 8192), 16, 0, 0); } while (0)
#define PG8_GOFFS(dst, un) do { _Pragma("unroll") for (int h_ = 0; h_ < 2; ++h_) _Pragma("unroll") for (int i_ = 0; i_ < 2; ++i_) { \
        int pos_ = (un).lt * 256 + h_ * 128 + gR[i_]; pos_ = pos_ < (un).cnt ? pos_ : 0; dst[h_][i_] = (unsigned)vtok[(un).e * 16384 + pos_] * (unsigned)(K * 2) + gC[i_]; } } while (0)
#define PG8_STAGE_A(bufoff, h, kt, nx) do { if constexpr (GATHER) { unsigned vo_[2]; vo_[0] = (nx) ? voffn[h][0] : voffc[h][0]; vo_[1] = (nx) ? voffn[h][1] : voffc[h][1]; \
            PG8_STAGE(bufoff, (const char*)g.A + (size_t)(kt) * kstep, vo_); } \
        else { PG8_STAGE(bufoff, ((nx) ? nA : cA) + (size_t)(kt) * kstep + (h) * hstep, voffA); } } while (0)
#define PG8_LDA(dst, b, h) do { _Pragma("unroll") for (int m = 0; m < 4; ++m) _Pragma("unroll") for (int k = 0; k < 2; ++k) dst[m][k] = *(const LAS bf16x8*)(lds + PG8_SA(b, h) + aoff + m * 2048 + k * 1024); } while (0)
#define PG8_LDB(dst, b, h) do { _Pragma("unroll") for (int n = 0; n < 2; ++n) _Pragma("unroll") for (int k = 0; k < 2; ++k) dst[n][k] = *(const LAS bf16x8*)(lds + PG8_SB(b, h) + boff + n * 2048 + k * 1024); } while (0)
#define PG8_MMA(ai, bj, At, Bt) do { __builtin_amdgcn_s_setprio(1); _Pragma("unroll") for (int m = 0; m < 4; ++m) _Pragma("unroll") for (int n = 0; n < 2; ++n) _Pragma("unroll") for (int k = 0; k < 2; ++k) \
        acc[ai][bj][m][n] = __builtin_amdgcn_mfma_f32_16x16x32_bf16(Bt[n][k], At[m][k], acc[ai][bj][m][n], 0, 0, 0); __builtin_amdgcn_s_setprio(0); } while (0)
#define PG8_WAIT_V(n) asm volatile("s_waitcnt vmcnt(" #n ")" ::: "memory")
#define PG8_WAIT_L(n) asm volatile("s_waitcnt lgkmcnt(" #n ")" ::: "memory")
#define PG8_BAR __builtin_amdgcn_s_barrier()
#define PG8_SCHED __builtin_amdgcn_sched_barrier(0)
    Unit cur, nxt; int ui = 0;
    if (!S.next(0, cur)) return;
    Acc acc;
#pragma unroll
    for (int a = 0; a < 2; ++a)
#pragma unroll
        for (int b = 0; b < 2; ++b)
#pragma unroll
            for (int m = 0; m < 4; ++m)
#pragma unroll
                for (int n = 0; n < 2; ++n) acc[a][b][m][n] = (f32x4){0.f, 0.f, 0.f, 0.f};
    bf16x8 At[4][2], B0[2][2], B1[2][2];
    const char* cA = (const char*)g.A + (size_t)cur.pm * tstep; const char* cB = (const char*)g.Bt + (size_t)cur.pb * tstep; const char* nA = cA;
    if constexpr (GATHER) { PG8_GOFFS(voffc, cur); asm volatile("s_waitcnt vmcnt(0)" ::: "memory"); }
    PG8_STAGE(PG8_SB(0, 0), cB, voffB); PG8_STAGE(PG8_SB(0, 1), cB + hstep, voffB); PG8_STAGE_A(PG8_SA(0, 0), 0, 0, false); PG8_STAGE_A(PG8_SA(0, 1), 1, 0, false);
    if (wr == 1) PG8_BAR;
    PG8_WAIT_V(2); PG8_BAR;
    PG8_STAGE(PG8_SB(1, 0), cB + kstep, voffB); PG8_STAGE_A(PG8_SA(1, 0), 0, 1, false); PG8_STAGE(PG8_SB(1, 1), cB + hstep + kstep, voffB);
    PG8_WAIT_V(6); PG8_BAR;
    for (;;) {
        const bool has_next = S.next(ui + 1, nxt);
        nA = has_next ? (const char*)g.A + (size_t)nxt.pm * tstep : cA; const char* nB = has_next ? (const char*)g.Bt + (size_t)nxt.pb * tstep : cB;
        if constexpr (GATHER) { if (has_next) PG8_GOFFS(voffn, nxt); else { voffn[0][0] = voffc[0][0]; voffn[0][1] = voffc[0][1]; voffn[1][0] = voffc[1][0]; voffn[1][1] = voffc[1][1]; }
            asm volatile("s_waitcnt vmcnt(0)" ::: "memory"); }
        for (int t = 0; t < nt; t += 2) {
            const bool last = (t == nt - 2);
            const int k2 = last ? 0 : t + 2, k3 = k2 + 1;
            const char* b2 = last ? nB : cB + (size_t)(t + 2) * kstep; const char* b3 = b2 + kstep;
            PG8_LDB(B0, 0, 0); PG8_LDB(B1, 0, 1); PG8_SCHED; PG8_LDA(At, 0, 0); PG8_STAGE_A(PG8_SA(1, 1), 1, t + 1, false);
            PG8_WAIT_V(8); PG8_WAIT_L(0); PG8_BAR; PG8_MMA(0, 0, At, B0); PG8_MMA(0, 1, At, B1); PG8_BAR; PG8_SCHED;
            PG8_LDA(At, 0, 1); PG8_STAGE(PG8_SB(0, 0), b2, voffB); PG8_STAGE(PG8_SB(0, 1), b2 + hstep, voffB); PG8_STAGE_A(PG8_SA(0, 0), 0, k2, last);
            PG8_WAIT_V(8); PG8_WAIT_L(0); PG8_BAR; PG8_MMA(1, 0, At, B0); PG8_MMA(1, 1, At, B1); PG8_BAR; PG8_SCHED;
            PG8_LDB(B0, 1, 0); PG8_LDB(B1, 1, 1); PG8_SCHED; PG8_LDA(At, 1, 0); PG8_STAGE_A(PG8_SA(0, 1), 1, k2, last);
            PG8_WAIT_V(8); PG8_WAIT_L(0); PG8_BAR; PG8_MMA(0, 0, At, B0); PG8_MMA(0, 1, At, B1); PG8_BAR; PG8_SCHED;
            PG8_LDA(At, 1, 1); PG8_STAGE(PG8_SB(1, 0), b3, voffB); PG8_STAGE(PG8_SB(1, 1), b3 + hstep, voffB); PG8_STAGE_A(PG8_SA(1, 0), 0, k3, last);
            PG8_WAIT_V(8); PG8_WAIT_L(0); PG8_BAR; PG8_MMA(1, 0, At, B0); PG8_MMA(1, 1, At, B1); PG8_BAR; PG8_SCHED;
        }
        if (wr == 0) PG8_BAR;
        E(acc, cur, wr, wc, fr, fq);
        if (!has_next) break;
#pragma unroll
        for (int a = 0; a < 2; ++a)
#pragma unroll
            for (int b = 0; b < 2; ++b)
#pragma unroll
                for (int m = 0; m < 4; ++m)
#pragma unroll
                    for (int n = 0; n < 2; ++n) acc[a][b][m][n] = (f32x4){0.f, 0.f, 0.f, 0.f};
        cur = nxt; cA = nA; cB = nB; ++ui;
        if constexpr (GATHER) { voffc[0][0] = voffn[0][0]; voffc[0][1] = voffn[0][1]; voffc[1][0] = voffn[1][0]; voffc[1][1] = voffn[1][1]; }
        if (wr == 1) PG8_BAR;
    }
    PG8_WAIT_V(0);
    PG8_BAR;
#undef PG8_SA
#undef PG8_SB
#undef PG8_STAGE
#undef PG8_LDA
#undef PG8_GOFFS
#undef PG8_STAGE_A
#undef PG8_LDB
#undef PG8_MMA
#undef PG8_WAIT_V
#undef PG8_WAIT_L
#undef PG8_BAR
#undef PG8_SCHED
}

__device__ __forceinline__ u32x4 pack8(f32x4 a, f32x4 b) { u32x4 w; w.x = cvt_pk_bf16(a[0], a[1]); w.y = cvt_pk_bf16(a[2], a[3]); w.z = cvt_pk_bf16(b[0], b[1]); w.w = cvt_pk_bf16(b[2], b[3]); return w; }
__device__ __forceinline__ void rope8(f32x4& a, f32x4& b, const float* tabrow, int i0) {
    const f32x4 t0 = *(const f32x4*)(tabrow + 2 * i0), t1 = *(const f32x4*)(tabrow + 2 * i0 + 4);
    const float a0 = a[0] * t0[0] - a[1] * t0[1], a1 = a[1] * t0[0] + a[0] * t0[1];
    const float a2 = a[2] * t0[2] - a[3] * t0[3], a3 = a[3] * t0[2] + a[2] * t0[3];
    const float b0 = b[0] * t1[0] - b[1] * t1[1], b1 = b[1] * t1[0] + b[0] * t1[1];
    const float b2 = b[2] * t1[2] - b[3] * t1[3], b3 = b[3] * t1[2] + b[2] * t1[3];
    a = (f32x4){a0, a1, a2, a3}; b = (f32x4){b0, b1, b2, b3};
}
__device__ __forceinline__ float sq8(f32x4 a, f32x4 b) { return (a[0] * a[0] + a[1] * a[1]) + (a[2] * a[2] + a[3] * a[3]) + (b[0] * b[0] + b[1] * b[1]) + (b[2] * b[2] + b[3] * b[3]); }

struct EpiIn {
    bf16_t* Qa; bf16_t* KVa; bf16_t* CQ; bf16_t* CKV; bf16_t* KR; float* SSQ; float* SSKV; const float* rope;
    __device__ __forceinline__ void operator()(const Acc& acc, const Unit& u, int wr, int wc, int, int) const {
        const int lane_ = opaque_tid() & 63, fr = lane_ & 15, fq = lane_ >> 4;
        const int row0 = u.pm * BM + wr * 64 + fr, c8 = wc * 32 + 8 * fq;
#pragma unroll
        for (int ai = 0; ai < 2; ++ai)
#pragma unroll
            for (int m = 0; m < 4; ++m) {
                const int row = row0 + ai * HALF + m * 16; const float* tab = rope + (size_t)(row & (SEQ - 1)) * 64;
                if (u.pn < 4) {
#pragma unroll
                    for (int bj = 0; bj < 2; ++bj) { f32x4 a = acc[ai][bj][m][0], b = acc[ai][bj][m][1]; const int col = bj * HALF + c8;
                        rope8(a, b, tab, (col & 63) >> 1); a = a * C2SWA; b = b * C2SWA;
                        *(u32x4*)(Qa + (size_t)row * DM + u.pn * BM + col) = pack8(a, b); }
                } else if (u.pn == 4) {
                    { f32x4 a = acc[ai][0][m][0], b = acc[ai][0][m][1]; rope8(a, b, tab, (c8 & 63) >> 1); *(u32x4*)(KVa + (size_t)row * 256 + c8) = pack8(a, b); }
                    { *(u32x4*)(KVa + (size_t)row * 256 + HALF + c8) = pack8(acc[ai][1][m][0], acc[ai][1][m][1]); }
                } else if (u.pn == 5) {
                    float s = 0.f;
#pragma unroll
                    for (int bj = 0; bj < 2; ++bj) { const f32x4 a = acc[ai][bj][m][0], b = acc[ai][bj][m][1]; s += sq8(a, b);
                        *(u32x4*)(CQ + (size_t)row * 256 + bj * HALF + c8) = pack8(a, b); }
                    s += __shfl_xor(s, 16); s += __shfl_xor(s, 32);
                    if (fq == 0) SSQ[(size_t)row * 4 + wc] = s;
                } else {
                    { const f32x4 a = acc[ai][0][m][0], b = acc[ai][0][m][1]; float s = sq8(a, b);
                      *(u32x4*)(CKV + (size_t)row * 128 + c8) = pack8(a, b);
                      s += __shfl_xor(s, 16); s += __shfl_xor(s, 32);
                      if (fq == 0) SSKV[(size_t)row * 4 + wc] = s; }
                    if (wc < 2) { f32x4 a = acc[ai][1][m][0], b = acc[ai][1][m][1]; rope8(a, b, tab, c8 >> 1); *(u32x4*)(KR + (size_t)row * 64 + c8) = pack8(a, b); }
                }
            }
    }
};
struct EpiRows {
    bf16_t* O; int ldc; const float* SS; float inv_n; float mul; int rope_pn0; const float* rope;
    __device__ __forceinline__ void operator()(const Acc& acc, const Unit& u, int wr, int wc, int, int) const {
        const int lane_ = opaque_tid() & 63, fr = lane_ & 15, fq = lane_ >> 4;
        const int row0 = u.pm * BM + wr * 64 + fr, c8 = wc * 32 + 8 * fq;
#pragma unroll
        for (int ai = 0; ai < 2; ++ai)
#pragma unroll
            for (int m = 0; m < 4; ++m) {
                const int row = row0 + ai * HALF + m * 16;
                float r = mul;
                if (SS) { const f32x4 s4 = *(const f32x4*)(SS + (size_t)row * 4); r = mul * __builtin_amdgcn_rsqf(((s4[0] + s4[1]) + (s4[2] + s4[3])) * inv_n + EPS); }
#pragma unroll
                for (int bj = 0; bj < 2; ++bj) { f32x4 a = acc[ai][bj][m][0] * r, b = acc[ai][bj][m][1] * r; const int col = bj * HALF + c8;
                    if (u.pn >= rope_pn0) rope8(a, b, rope + (size_t)(row & (SEQ - 1)) * 64, (col & 63) >> 1);
                    *(u32x4*)(O + (size_t)row * ldc + u.pn * BM + col) = pack8(a, b); }
            }
    }
};
struct EpiGate {
    const bf16_t* OA; const bf16_t* OB; int ldb; bf16_t* MG;
    __device__ __forceinline__ void operator()(const Acc& acc, const Unit& u, int wr, int wc, int, int) const {
        const int lane_ = opaque_tid() & 63, fr = lane_ & 15, fq = lane_ >> 4;
        const int row0 = u.pm * BM + wr * 64 + fr, col = u.pn * HALF + wc * 32 + 8 * fq;
#pragma unroll
        for (int ai = 0; ai < 2; ++ai)
#pragma unroll
            for (int m = 0; m < 4; ++m) {
                const int row = row0 + ai * HALF + m * 16;
                const u32x4 oa = *(const u32x4*)(OA + (size_t)row * DM + col), ob = *(const u32x4*)(OB + (size_t)row * ldb + col);
                f32x4 r0, r1;
#pragma unroll
                for (int j = 0; j < 4; ++j) {
                    const float ga = fsigmoid(acc[ai][0][m][j >> 1][(j & 1) * 2]), ga1 = fsigmoid(acc[ai][0][m][j >> 1][(j & 1) * 2 + 1]);
                    const float gb = fsigmoid(acc[ai][1][m][j >> 1][(j & 1) * 2]), gb1 = fsigmoid(acc[ai][1][m][j >> 1][(j & 1) * 2 + 1]);
                    const float v0 = ga * bf_lo(oa[j]) + gb * bf_lo(ob[j]), v1 = ga1 * bf_hi(oa[j]) + gb1 * bf_hi(ob[j]);
                    if (j < 2) { r0[2 * j] = v0; r0[2 * j + 1] = v1; } else { r1[2 * (j - 2)] = v0; r1[2 * (j - 2) + 1] = v1; }
                }
                *(u32x4*)(MG + (size_t)row * DM + col) = pack8(r0, r1);
            }
    }
};
struct EpiRes {
    const float* X; float* H; bf16_t* HB;
    __device__ __forceinline__ void operator()(const Acc& acc, const Unit& u, int wr, int wc, int, int) const {
        const int lane_ = opaque_tid() & 63, fr = lane_ & 15, fq = lane_ >> 4;
        const int row0 = u.pm * BM + wr * 64 + fr, c8 = wc * 32 + 8 * fq;
#pragma unroll
        for (int ai = 0; ai < 2; ++ai)
#pragma unroll
            for (int m = 0; m < 4; ++m) {
                const int row = row0 + ai * HALF + m * 16;
#pragma unroll
                for (int bj = 0; bj < 2; ++bj) { const size_t off = (size_t)row * DM + u.pn * BM + bj * HALF + c8;
                    const f32x4 a = *(const f32x4*)(X + off) + acc[ai][bj][m][0], b = *(const f32x4*)(X + off + 4) + acc[ai][bj][m][1];
                    *(f32x4*)(H + off) = a; *(f32x4*)(H + off + 4) = b; *(u32x4*)(HB + off) = pack8(a, b); }
            }
    }
};
struct EpiMoeIn {
    const float* VR; const float* VCW; bf16_t* ACT;
    __device__ __forceinline__ void operator()(const Acc& acc, const Unit& u, int wr, int wc, int, int) const {
        const int lane_ = opaque_tid() & 63, fr = lane_ & 15, fq = lane_ >> 4;
        const int rl0 = wr * 64 + fr, col = u.pn * HALF + wc * 32 + 8 * fq;
#pragma unroll
        for (int ai = 0; ai < 2; ++ai)
#pragma unroll
            for (int m = 0; m < 4; ++m) {
                const int rl = rl0 + ai * HALF + m * 16; int pos = u.lt * 256 + rl; pos = pos < u.cnt ? pos : 0;
                const float r = VR[u.e * 16384 + pos], cw = VCW[u.e * 16384 + pos];
                f32x4 o[2];
#pragma unroll
                for (int n = 0; n < 2; ++n)
#pragma unroll
                    for (int j = 0; j < 4; ++j) { const float gt = r * acc[ai][0][m][n][j], up = r * acc[ai][1][m][n][j]; o[n][j] = gt * fsigmoid(gt) * up * cw; }
                *(u32x4*)(ACT + (size_t)(u.pm * BM + rl) * DEXP + col) = pack8(o[0], o[1]);
            }
    }
};
struct EpiPle {
    float* H; const bf16_t* PP; const float* SS2;
    __device__ __forceinline__ void operator()(const Acc& acc, const Unit& u, int wr, int wc, int, int) const {
        const int lane_ = opaque_tid() & 63, fr = lane_ & 15, fq = lane_ >> 4;
        const int row0 = u.pm * BM + wr * 64 + fr, c8 = wc * 32 + 8 * fq;
#pragma unroll
        for (int ai = 0; ai < 2; ++ai)
#pragma unroll
            for (int m = 0; m < 4; ++m) {
                const int row = row0 + ai * HALF + m * 16; const float r = __builtin_amdgcn_rsqf(SS2[row] * (1.f / DM) + EPS);
#pragma unroll
                for (int bj = 0; bj < 2; ++bj) { const size_t off = (size_t)row * DM + u.pn * BM + bj * HALF + c8;
                    const u32x4 pp = *(const u32x4*)(PP + off); f32x4 a = *(const f32x4*)(H + off), b = *(const f32x4*)(H + off + 4);
                    const f32x4 g0 = acc[ai][bj][m][0] * r, g1 = acc[ai][bj][m][1] * r;
                    a[0] += fsigmoid(g0[0]) * bf_lo(pp[0]); a[1] += fsigmoid(g0[1]) * bf_hi(pp[0]); a[2] += fsigmoid(g0[2]) * bf_lo(pp[1]); a[3] += fsigmoid(g0[3]) * bf_hi(pp[1]);
                    b[0] += fsigmoid(g1[0]) * bf_lo(pp[2]); b[1] += fsigmoid(g1[1]) * bf_hi(pp[2]); b[2] += fsigmoid(g1[2]) * bf_lo(pp[3]); b[3] += fsigmoid(g1[3]) * bf_hi(pp[3]);
                    *(f32x4*)(H + off) = a; *(f32x4*)(H + off + 4) = b; }
            }
    }
};
}

namespace att {
__device__ __forceinline__ int v_st(int k, int c) { const int kk = (k & ~0xC) | ((k & 4) << 1) | ((k & 8) >> 1); return ((kk >> 3) * 4 + (c >> 5)) * 512 + ((kk & 7) * 32 + (c & 31)) * 2; }
__device__ __forceinline__ int v_rd_base(int lane) { return ((lane & 3) << 3) | (((lane >> 2) & 3) << 6) | (((lane >> 4) & 1) << 5) | (((lane >> 5) & 1) << 8); }
__device__ __forceinline__ int crow(int r, int hi) { return (r & 3) + 8 * (r >> 2) + 4 * hi; }
typedef short v4i16_t __attribute__((ext_vector_type(4)));
__device__ __forceinline__ s16x4 vtr(const LAS char* p) { return __builtin_bit_cast(s16x4, __builtin_amdgcn_ds_read_tr16_b64_v4i16((LAS v4i16_t*)p)); }
__device__ __forceinline__ void mask_tile(f32x16& p0, f32x16& p1, int dq, unsigned W) {
    const float NEG = -__builtin_inff();
#pragma unroll
    for (int r = 0; r < 16; ++r) {
        const int c = (r & 3) + 8 * (r >> 2);
        if ((unsigned)(dq - c) >= W) p0[r] = NEG;
        if ((unsigned)(dq - c - 32) >= W) p1[r] = NEG;
    }
}
constexpr float THR = 10.f;
template <int DQK, int DV> struct Geo { static constexpr int KROW = DQK * 2 + 16, KBUF = 64 * KROW, VBUF = 16384, LDS_V = 2 * KBUF, LDS_S = LDS_V + 2 * VBUF, LDS_BYTES = LDS_S + 8 * 256; };

template <int DQK, int DV, int K1W, int VAR = 0>
__device__ __forceinline__ void attn_unit(LAS char* lds, const bf16_t* q1, const bf16_t* q2, int QP,
                                          const bf16_t* K1, int K1P, const bf16_t* K2, int K2P, const bf16_t* Vp, int VP,
                                          int j_lo, int j_hi, int qlo, unsigned W, float m0, float l0, bf16_t* ow, int OP) {
    typedef Geo<DQK, DV> G;
    constexpr int NQF = DQK / 16, ND0 = DV / 32, K1C = K1W / 8, K2C = (DQK - K1W) / 8, VC = DV / 8;
    constexpr int NK1 = (64 * K1C) / 512, NK2 = (64 * K2C + 511) / 512, NV = (64 * VC) / 512;
    static_assert(NK1 >= 1 && NK1 <= 2 && NK2 <= 1 && NV >= 1 && NV <= 2, "staging geometry");
    const int tid = opaque_tid(), lane = tid & 63, r32 = lane & 31, hi = lane >> 5; const int wid = __builtin_amdgcn_readfirstlane(tid >> 6);
    LAS float* wsf = (LAS float*)(lds + G::LDS_S) + wid * 64;
    bf16x8 qr[NQF];
#pragma unroll
    for (int d0 = 0; d0 < NQF; ++d0) {
        if (d0 * 16 < K1W) qr[d0] = *(const bf16x8*)(q1 + (size_t)r32 * QP + d0 * 16 + hi * 8);
        else qr[d0] = *(const bf16x8*)(q2 + (size_t)r32 * QP + (d0 * 16 - K1W) + hi * 8);
    }
    const int k1r = tid / K1C, k1c = tid % K1C;
    const int k2r = K2C ? tid / (K2C ? K2C : 1) : 0, k2c = K2C ? tid % (K2C ? K2C : 1) : 0;
    const int vr = tid / VC, vc = tid % VC;
    bf16x8 sk1[NK1], sk2[NK2 ? NK2 : 1], sv[NV];
#define ATT_LOAD(kb) do { \
        _Pragma("unroll") for (int i = 0; i < NK1; ++i) sk1[i] = *(const bf16x8*)(K1 + (size_t)((kb) + k1r + i * (512 / K1C)) * K1P + k1c * 8); \
        if (NK2) sk2[0] = *(const bf16x8*)(K2 + (size_t)((kb) + k2r) * K2P + k2c * 8); \
        _Pragma("unroll") for (int i = 0; i < NV; ++i) sv[i] = *(const bf16x8*)(Vp + (size_t)((kb) + vr + i * (512 / VC)) * VP + vc * 8); } while (0)
#define ATT_WRITE(buf) do { \
        _Pragma("unroll") for (int i = 0; i < NK1; ++i) *(LAS bf16x8*)(lds + (buf) * G::KBUF + (k1r + i * (512 / K1C)) * G::KROW + k1c * 16) = sk1[i]; \
        if (NK2) *(LAS bf16x8*)(lds + (buf) * G::KBUF + k2r * G::KROW + (K1C + k2c) * 16) = sk2[0]; \
        _Pragma("unroll") for (int i = 0; i < NV; ++i) *(LAS bf16x8*)(lds + G::LDS_V + (buf) * G::VBUF + v_st(vr + i * (512 / VC), vc * 8)) = sv[i]; } while (0)
    float m_reg = m0, l_reg = l0;
    f32x16 o[ND0];
#pragma unroll
    for (int d = 0; d < ND0; ++d) o[d] = f32x16{};
    const int qm = qlo + r32 - 4 * hi;
    const int NT = j_hi - j_lo;
    ATT_LOAD(j_lo * 64);
    ATT_WRITE(0);
    __syncthreads();
#pragma unroll
    for (int d0 = 0; d0 < NQF; ++d0) asm volatile("" : "+v"(qr[d0]));
    const LAS char* kp0 = lds + r32 * G::KROW + hi * 16;
    const LAS char* vp0 = lds + G::LDS_V + v_rd_base(lane);
    for (int t = 0; t < NT; ++t) {
        const int buf = t & 1, kb = (j_lo + t) * 64;
        if (VAR != 3 && t + 1 < NT) ATT_LOAD(kb + 64);
        f32x16 p0 = f32x16{}, p1 = f32x16{};
        if (VAR != 5) { const LAS char* kp = kp0 + buf * G::KBUF;
#pragma unroll
          for (int d0 = 0; d0 < NQF; ++d0) {
              const bf16x8 b0 = *(const LAS bf16x8*)(kp + d0 * 32), b1 = *(const LAS bf16x8*)(kp + 32 * G::KROW + d0 * 32);
              p0 = __builtin_amdgcn_mfma_f32_32x32x16_bf16(b0, qr[d0], p0, 0, 0, 0);
              p1 = __builtin_amdgcn_mfma_f32_32x32x16_bf16(b1, qr[d0], p1, 0, 0, 0); } }
        if (kb + 63 > qlo || (long)kb <= (long)qlo + 31 - (long)W) mask_tile(p0, p1, qm - kb, W);
        float alpha = 1.f;
        if (VAR != 2) {
        float pmax = p0[0];
#pragma unroll
        for (int r = 1; r < 16; ++r) pmax = fmaxf(pmax, p0[r]);
#pragma unroll
        for (int r = 0; r < 16; ++r) pmax = fmaxf(pmax, p1[r]);
        { auto rr = __builtin_amdgcn_permlane32_swap(__float_as_uint(pmax), __float_as_uint(pmax), false, false);
          pmax = fmaxf(__uint_as_float(rr[0]), __uint_as_float(rr[1])); }
        if (!__all(pmax - m_reg <= THR)) {
            const float mn = fmaxf(m_reg, pmax); alpha = __builtin_amdgcn_exp2f(m_reg - mn); m_reg = mn;
            if (hi == 0) wsf[r32] = alpha;
#pragma unroll
            for (int d = 0; d < ND0; ++d)
#pragma unroll
                for (int r = 0; r < 16; ++r) o[d][r] *= wsf[crow(r, hi)];
        }
        float ps = 0.f;
#pragma unroll
        for (int r = 0; r < 16; ++r) { p0[r] = (VAR == 1) ? (p0[r] - m_reg) : __builtin_amdgcn_exp2f(p0[r] - m_reg); ps += p0[r]; }
#pragma unroll
        for (int r = 0; r < 16; ++r) { p1[r] = (VAR == 1) ? (p1[r] - m_reg) : __builtin_amdgcn_exp2f(p1[r] - m_reg); ps += p1[r]; }
        { auto rr = __builtin_amdgcn_permlane32_swap(__float_as_uint(ps), __float_as_uint(ps), false, false);
          ps = __uint_as_float(rr[0]) + __uint_as_float(rr[1]); }
        l_reg = l_reg * alpha + ps;
        }
        bf16x8 pa0, pa1, pa2, pa3;
#define PK4(P, B_, OUT) do { unsigned a0 = cvt_pk_bf16(P[B_+0], P[B_+1]), a1 = cvt_pk_bf16(P[B_+2], P[B_+3]); \
        unsigned b0_ = cvt_pk_bf16(P[B_+4], P[B_+5]), b1_ = cvt_pk_bf16(P[B_+6], P[B_+7]); \
        auto r0 = __builtin_amdgcn_permlane32_swap(a0, b0_, false, false); auto r1 = __builtin_amdgcn_permlane32_swap(a1, b1_, false, false); \
        u32x4 w = {r0[0], r1[0], r0[1], r1[1]}; OUT = __builtin_bit_cast(bf16x8, w); } while (0)
        PK4(p0, 0, pa0); PK4(p0, 8, pa1); PK4(p1, 0, pa2); PK4(p1, 8, pa3);
#undef PK4
        if (VAR != 3 && t + 1 < NT) ATT_WRITE(buf ^ 1);
        if (VAR == 4) { asm volatile("" :: "v"(pa0), "v"(pa1), "v"(pa2), "v"(pa3)); }
        else { const LAS char* vp = vp0 + buf * G::VBUF;
          s16x4 la[4], ha[4], lb[4], hb[4];
#define VLOAD(L, H, d0) do { _Pragma("unroll") for (int ks = 0; ks < 4; ++ks) { L[ks] = vtr(vp + (d0) * 512 + ks * 4096); H[ks] = vtr(vp + (d0) * 512 + ks * 4096 + 2048); } } while (0)
#define VF(L, H, k) (bf16x8){L[k][0], L[k][1], L[k][2], L[k][3], H[k][0], H[k][1], H[k][2], H[k][3]}
#define VMMA(L, H, d0) do { o[d0] = __builtin_amdgcn_mfma_f32_32x32x16_bf16(pa0, VF(L, H, 0), o[d0], 0, 0, 0); o[d0] = __builtin_amdgcn_mfma_f32_32x32x16_bf16(pa1, VF(L, H, 1), o[d0], 0, 0, 0); \
              o[d0] = __builtin_amdgcn_mfma_f32_32x32x16_bf16(pa2, VF(L, H, 2), o[d0], 0, 0, 0); o[d0] = __builtin_amdgcn_mfma_f32_32x32x16_bf16(pa3, VF(L, H, 3), o[d0], 0, 0, 0); } while (0)
          VLOAD(la, ha, 0);
#pragma unroll
          for (int d0 = 0; d0 < ND0; d0 += 2) {
              if (d0 + 1 < ND0) VLOAD(lb, hb, d0 + 1);
              VMMA(la, ha, d0);
              if (d0 + 2 < ND0) VLOAD(la, ha, d0 + 2);
              if (d0 + 1 < ND0) VMMA(lb, hb, d0 + 1);
          }
#undef VLOAD
#undef VF
#undef VMMA
        }
        __syncthreads();
    }
#undef ATT_LOAD
#undef ATT_WRITE
    if (hi == 0) wsf[32 + r32] = l_reg;
    float rli[16];
#pragma unroll
    for (int r = 0; r < 16; ++r) rli[r] = __builtin_amdgcn_rcpf(wsf[32 + crow(r, hi)]);
#pragma unroll
    for (int r = 0; r < 16; ++r) { const int orow = crow(r, hi);
#pragma unroll
        for (int d0 = 0; d0 < ND0; ++d0) { const float v = o[d0][r] * rli[r]; const float vn = __shfl_xor(v, 1);
            if ((r32 & 1) == 0) *(unsigned*)(ow + (size_t)orow * OP + d0 * 32 + r32) = cvt_pk_bf16(v, vn); } }
}
}

constexpr int NWAVES = 8;
constexpr size_t MiB = 1u << 20, KiB = 1u << 10;
constexpr size_t WS_CTL = 0, CTL_ZERO_BYTES = 64 * KiB;
constexpr size_t WS_META = 64 * KiB;
constexpr size_t WS_SSQ = 1 * MiB, WS_SSKV = WS_SSQ + 256 * KiB, WS_SS2 = WS_SSKV + 256 * KiB;
constexpr size_t WS_TOKE = WS_SS2 + 64 * KiB, WS_TOKPOS = WS_TOKE + 64 * KiB, WS_TOKCW = WS_TOKPOS + 128 * KiB, WS_TOKR = WS_TOKCW + 128 * KiB, WS_TOKSLOT = WS_TOKR + 64 * KiB;
constexpr size_t WS_RG = WS_TOKSLOT + 128 * KiB, WS_CWS = WS_RG + 256 * KiB, WS_WR = WS_CWS + 256 * KiB;
static_assert(WS_WR + 80 * KiB <= 4 * MiB, "small arrays");
constexpr size_t WS_ROPE = 4 * MiB, WS_VR = 3 * MiB, WS_VTOK = 6 * MiB, WS_VCW = 7 * MiB;
constexpr size_t WS_WIN = 8 * MiB, WS_WG = 12 * MiB, WS_WUQ = 16 * MiB, WS_WUKV = 17 * MiB, WS_WOUT = 18 * MiB, WS_WEI = 20 * MiB, WS_WEO = 36 * MiB, WS_WPG = 44 * MiB, WS_WPP = 46 * MiB;
constexpr size_t WS_XN = 48 * MiB, WS_PB = 80 * MiB, WS_PP = 88 * MiB, WS_QA = 120 * MiB, WS_KVA = 152 * MiB, WS_CQ = 160 * MiB, WS_CKV = 168 * MiB, WS_KR = 172 * MiB,
                 WS_Q = 174 * MiB, WS_MG = 222 * MiB, WS_XG = 120 * MiB, WS_ACT = 192 * MiB, WS_Y = 120 * MiB, WS_HB = 48 * MiB, WS_END = 256 * MiB;
static_assert(WS_Q + (size_t)T_TOK * QW * 2 <= WS_MG && WS_MG + (size_t)T_TOK * DM * 2 <= WS_END && WS_XG + (size_t)MAXSLOTS * DM * 2 <= WS_ACT && WS_ACT + (size_t)MAXSLOTS * DEXP * 2 <= WS_MG, "d_ws map");
constexpr int CW_BAR = 1024, CW_CNT = 8192;
constexpr int RING_BYTES = 131072, LDSCTL_OFF = RING_BYTES, MISC_OFF = LDSCTL_OFF + 320, LDS_BYTES = 147456;

typedef GAS unsigned gu32;
#define RLX_AGENT __ATOMIC_RELAXED, __HIP_MEMORY_SCOPE_AGENT
#define LDS_WAIT() asm volatile("s_waitcnt lgkmcnt(0)" ::: "memory")

#define XB_TMO      128
#define XB_XCNT(j)  (256  + 64 * (j))
#define XB_XSUB(j)  (1280 + 64 * (j))
#define XB_XGEN(j)  (2304 + 64 * (j))
#define XB_TOP      3328
#define XB_TOPGEN   3392
#define XCD_BAR_WORDS 3456
#define XB_SPIN_CAP (1u << 18)
__device__ __forceinline__ unsigned xb_ld(unsigned* p)              { return __hip_atomic_load(p, __ATOMIC_RELAXED, __HIP_MEMORY_SCOPE_AGENT); }
__device__ __forceinline__ unsigned xb_add(unsigned* p, unsigned v) { return __hip_atomic_fetch_add(p, v, __ATOMIC_RELAXED, __HIP_MEMORY_SCOPE_AGENT); }
__device__ __forceinline__ unsigned xb_xcc_id() { return (unsigned)__builtin_amdgcn_s_getreg((3 << 11) | 20) & 0xFu; }
#define XB_SPIN(cond, bar) do { unsigned _sp = 0; while (cond) { __builtin_amdgcn_s_sleep(1); \
    if ((++_sp & 255u) == 0u) { if (xb_ld(&(bar)[XB_TMO])) break; if (_sp > XB_SPIN_CAP) { atomicAdd(&(bar)[XB_TMO], 1u); break; } } } } while (0)
struct XcdBarrier { unsigned* bar; unsigned x; volatile LAS unsigned* st; };
__device__ __forceinline__ XcdBarrier xcd_barrier_post(unsigned* bar, volatile LAS unsigned* st) {
    XcdBarrier b; b.bar = bar; b.x = xb_xcc_id(); b.st = st;
    if (threadIdx.x == 0) (void)xb_add(&bar[XB_XCNT(b.x)], 1u);
    return b;
}
__device__ __forceinline__ void xcd_barrier_complete(unsigned* bar, unsigned x, unsigned& nloc, unsigned& nx) {
    const unsigned G = gridDim.x * gridDim.y * gridDim.z;
    unsigned sum, cnt, mine, sp = 0u;
    for (;;) {
        sum = 0u; cnt = 0u; mine = 0u;
#pragma unroll
        for (unsigned j = 0; j < 16; ++j) { const unsigned c = xb_ld(&bar[XB_XCNT(j)]); sum += c; cnt += (c > 0u) ? 1u : 0u; mine = (j == x) ? c : mine; }
        if (sum == G) break;
        __builtin_amdgcn_s_sleep(1);
        if ((++sp & 255u) == 0u) { if (xb_ld(&bar[XB_TMO])) break; if (sp > XB_SPIN_CAP) { atomicAdd(&bar[XB_TMO], 1u); break; } }
    }
    nloc = mine > 0u ? mine : 1u; nx = cnt > 0u ? cnt : 1u;
}
__device__ __forceinline__ void xcd_barrier(const XcdBarrier& b) {
    asm volatile("s_waitcnt vmcnt(0)" ::: "memory");
    __syncthreads();
    if (threadIdx.x == 0) {
        unsigned* bar = b.bar;
        __builtin_amdgcn_s_waitcnt(0);
        unsigned nloc = b.st[0], nx = b.st[1];
        if (nloc == 0u) { xcd_barrier_complete(bar, b.x, nloc, nx); b.st[0] = nloc; b.st[1] = nx; }
        const unsigned old = xb_add(&bar[XB_XSUB(b.x)], 1u);
        const unsigned gen = old / nloc;
        if (old + 1u == (gen + 1u) * nloc) {
            __builtin_amdgcn_fence(__ATOMIC_RELEASE, "agent");
            asm volatile("s_waitcnt vmcnt(0)" ::: "memory");
            const unsigned og = xb_add(&bar[XB_TOP], 1u);
            const unsigned tg = og / nx;
            if (og + 1u == (tg + 1u) * nx) xb_add(&bar[XB_TOPGEN], 1u);
            else XB_SPIN(xb_ld(&bar[XB_TOPGEN]) == tg, bar);
            __builtin_amdgcn_fence(__ATOMIC_ACQUIRE, "agent");
            xb_add(&bar[XB_XGEN(b.x)], 1u);
            asm volatile("s_waitcnt vmcnt(0)" ::: "memory");
        } else {
            XB_SPIN(xb_ld(&bar[XB_XGEN(b.x)]) == gen, bar);
            __builtin_amdgcn_fence(__ATOMIC_ACQUIRE, "agent");
            asm volatile("s_waitcnt vmcnt(0)" ::: "memory");
        }
    }
    __syncthreads();
}

__device__ __forceinline__ int pairdst(int j) { return j < 32 ? 2 * j : 2 * (j - 32) + 1; }
__device__ __forceinline__ int dst_row(int mat, int s) {
    switch (mat) {
    case 0:
        if (s < 1152) return (s & ~63) + pairdst(s & 63); if (s < 1664) return s; if (s < 1728) return 1664 + pairdst(s - 1664);
        if (s < 2752) { const int g = s - 1728; return 2048 + 256 * (g >> 7) + (g & 127); } { const int g = s - 2752; return 2048 + 256 * (g >> 7) + 128 + (g & 127); }
    case 2: { const int h = s / 192, j = s - h * 192; return j < 128 ? 128 * h + j : 1024 + 64 * h + pairdst(j - 128); }
    case 4: if (s < 256) return (s >> 7) * 256 + (s & 127); else { const int t = s - 256; return (t >> 7) * 256 + 128 + (t & 127); }
    default: return s;
    }
}
__device__ __forceinline__ void transpose_item(const float* W, int ldw, int K, int nsb, const float* gain, int mat, bf16_t* WT, LAS float* scr, int item, int lane) {
    const int kb = item / nsb, sb = item - kb * nsb, k0 = 64 * kb, s0 = 32 * sb;
    const int krow = lane >> 3, c4 = (lane & 7) * 4;
    f32x4 v[8];
#pragma unroll
    for (int i = 0; i < 8; ++i) v[i] = *(const f32x4*)(W + (size_t)(k0 + 8 * i + krow) * ldw + s0 + c4);
#pragma unroll
    for (int i = 0; i < 8; ++i) { const int kk = 8 * i + krow; const float gg = gain ? gain[k0 + kk] : 1.f; LAS float* d = scr + kk * 33 + c4;
        d[0] = v[i][0] * gg; d[1] = v[i][1] * gg; d[2] = v[i][2] * gg; d[3] = v[i][3] * gg; }
    LDS_WAIT(); asm volatile("" ::: "memory");
    const int c = lane & 7;
#pragma unroll
    for (int j = 0; j < 4; ++j) { const int n = (lane >> 3) + 8 * j; const LAS float* sp = scr + (8 * c) * 33 + n;
        u32x4 o; o.x = cvt_pk_bf16(sp[0 * 33], sp[1 * 33]); o.y = cvt_pk_bf16(sp[2 * 33], sp[3 * 33]); o.z = cvt_pk_bf16(sp[4 * 33], sp[5 * 33]); o.w = cvt_pk_bf16(sp[6 * 33], sp[7 * 33]);
        *(u32x4*)(WT + (size_t)dst_row(mat, s0 + n) * K + k0 + 8 * c) = o; }
    LDS_WAIT(); asm volatile("" ::: "memory");
}
__device__ __forceinline__ void sincos_d(float ang, float& c, float& s) {
    const double x = (double)ang, q = __builtin_rint(x * 0.63661977236758134308);
    double r = __builtin_fma(-q, 1.5707963267948966, x); r = __builtin_fma(-q, 6.123233995736766e-17, r);
    const double r2 = r * r;
    double sp = -1.0 / 1307674368000.0; sp = sp * r2 + 1.0 / 6227020800.0; sp = sp * r2 - 1.0 / 39916800.0; sp = sp * r2 + 1.0 / 362880.0; sp = sp * r2 - 1.0 / 5040.0; sp = sp * r2 + 1.0 / 120.0; sp = sp * r2 - 1.0 / 6.0; sp = sp * r2 + 1.0;
    const double sr = sp * r;
    double cp = 1.0 / 20922789888000.0; cp = cp * r2 - 1.0 / 87178291200.0; cp = cp * r2 + 1.0 / 479001600.0; cp = cp * r2 - 1.0 / 3628800.0; cp = cp * r2 + 1.0 / 40320.0; cp = cp * r2 - 1.0 / 720.0; cp = cp * r2 + 1.0 / 24.0; cp = cp * r2 - 0.5; cp = cp * r2 + 1.0;
    const int n = ((int)q) & 3;
    const double cc = (n == 0) ? cp : (n == 1) ? -sr : (n == 2) ? -cp : sr;
    const double ss = (n == 0) ? sr : (n == 1) ? cp : (n == 2) ? -sr : -cp;
    c = (float)cc; s = (float)ss;
}

typedef const __attribute__((address_space(4))) char* kptr_t;
__device__ __forceinline__ kptr_t kargp() { kptr_t p = (kptr_t)__builtin_amdgcn_kernarg_segment_ptr(); asm volatile("" : "+s"(p)); return p; }
template <class T> __device__ __forceinline__ T karg(kptr_t kp, int off) { return *(const __attribute__((address_space(4))) T*)(kp + off); }
#define KP_INIT kptr_t kp_ = kargp(); unsigned char* ws = karg<unsigned char*>(kp_, 176); (void)ws;
#define INP(i) karg<const float*>(kp_, 8 * (i))
#define OUTP karg<float*>(kp_, 168)
#define WSP(T, off) ((T*)(ws + (off)))
struct Args { const float* in[21]; float* out; unsigned char* ws; int ph_lo, ph_hi; };
constexpr int NPHASE = 13;

__global__ void __launch_bounds__(NWAVES * 64, 2) mk_fwd(Args) {
    extern __shared__ __attribute__((aligned(16))) unsigned char lds_raw[];
    LAS unsigned char* lds = (LAS unsigned char*)lds_raw;
    volatile LAS unsigned* MISC = (volatile LAS unsigned*)(lds + MISC_OFF);
    const int G = gridDim.x, bx = blockIdx.x, vcu = (G % 8 == 0) ? (bx % 8) * (G / 8) + bx / 8 : bx;
    const int NGW = G * NWAVES;
#define PH_IDS const int tid = opaque_tid(), lane = tid & 63, wave = __builtin_amdgcn_readfirstlane(tid >> 6), gw = vcu * NWAVES + wave; (void)lane; (void)gw;
    gu32* ctl; { KP_INIT ctl = (gu32*)(ws + WS_CTL); }
    { PH_IDS for (int u = tid; u < (LDS_BYTES - LDSCTL_OFF) / 4; u += NWAVES * 64) ((LAS unsigned*)(lds + LDSCTL_OFF))[u] = 0u; }
    __syncthreads();
    XcdBarrier bar; bar.bar = (unsigned*)(ctl + CW_BAR); bar.x = 0; bar.st = nullptr;
#if MK_ONE_LAUNCH
    bar = xcd_barrier_post((unsigned*)(ctl + CW_BAR), MISC + 8);
#define GRID_BAR() xcd_barrier(bar)
#else
#define GRID_BAR() do {} while (0)
#endif
    int lo, hi_ph; { KP_INIT lo = karg<int>(kp_, 184); hi_ph = karg<int>(kp_, 188); }
#ifndef PH_MASK
#define PH_MASK 0x1fff
#endif
#define IN(k) ((((PH_MASK) >> (k)) & 1) && lo <= (k) && (k) < hi_ph)
    unsigned long long t_p0 = 0, t_p1 = 0;
#define SEAM(k) do { if (IN(k) && IN((k) + 1)) GRID_BAR(); if ((k) == PROBE_HI) t_p1 = __builtin_amdgcn_s_memrealtime(); if ((k) + 1 == PROBE_LO) t_p0 = __builtin_amdgcn_s_memrealtime(); } while (0)

    if (PROBE_LO == 0) t_p0 = __builtin_amdgcn_s_memrealtime();
    if (IN(0)) { PH_IDS
        KP_INIT const float* x = INP(0); const float* p_in = INP(1); const float* g_mix = INP(2); const float* w_in = INP(3); const float* g_q = INP(5); const float* w_uq = INP(6); const float* g_kv = INP(7); const float* w_ukv = INP(8); const float* w_out = INP(9);
        const float* g_ffn = INP(10); const float* w_rg = INP(11); const float* w_re = INP(13); const float* w_ei = INP(15); const float* w_eo = INP(16); const float* g_ple = INP(17); const float* w_pg = INP(18); const float* w_pp = INP(19);
        bf16_t* Win_t = WSP(bf16_t, WS_WIN); bf16_t* Wg_t = WSP(bf16_t, WS_WG); bf16_t* Wuq_t = WSP(bf16_t, WS_WUQ); bf16_t* Wukv_t = WSP(bf16_t, WS_WUKV); bf16_t* Wout_t = WSP(bf16_t, WS_WOUT); bf16_t* Wei_t = WSP(bf16_t, WS_WEI);
        bf16_t* Weo_t = WSP(bf16_t, WS_WEO); bf16_t* Wpg_t = WSP(bf16_t, WS_WPG); bf16_t* Wpp_t = WSP(bf16_t, WS_WPP); bf16_t* XN = WSP(bf16_t, WS_XN); bf16_t* PB = WSP(bf16_t, WS_PB); float* WR = WSP(float, WS_WR); float* ROPE = WSP(float, WS_ROPE);
        LAS float* scr = (LAS float*)(lds + wave * 16384);
        constexpr int I_IN = 16 * 118, I_UQ = 4 * 48, I_UKV = 2 * 64, I_OUT = 16 * 32, I_EI1 = 16 * 16, I_EI = NEXP * I_EI1, I_EO1 = 4 * 32, I_EO = NEXP * I_EO1, I_PG = 16 * 32, I_PP = 4 * 32;
        constexpr int NITEMS = I_IN + I_UQ + I_UKV + I_OUT + I_EI + I_EO + I_PG + I_PP;
        (void)Wg_t;
        static_assert(WS_WG - WS_WIN == 2048 * 1024 * 2, "gate weights sit 2048 rows above Win_t");
        for (int it = gw; it < NITEMS; it += NGW) {
            int r = it;
            if (r < I_IN) { transpose_item(w_in, 3776, 1024, 118, nullptr, 0, Win_t, scr, r, lane); continue; } r -= I_IN;
            if (r < I_UQ) { transpose_item(w_uq, QW, 256, 48, g_q, 2, Wuq_t, scr, r, lane); continue; } r -= I_UQ;
            if (r < I_UKV) { transpose_item(w_ukv, KVW, 128, 64, g_kv, 3, Wukv_t, scr, r, lane); continue; } r -= I_UKV;
            if (r < I_OUT) { transpose_item(w_out, 1024, 1024, 32, nullptr, 3, Wout_t, scr, r, lane); continue; } r -= I_OUT;
            if (r < I_EI) { const int e = r / I_EI1; transpose_item(w_ei + (size_t)e * 1024 * 512, 512, 1024, 16, g_ffn, 4, Wei_t + (size_t)e * 512 * 1024, scr, r % I_EI1, lane); continue; } r -= I_EI;
            if (r < I_EO) { const int e = r / I_EO1; transpose_item(w_eo + (size_t)e * 256 * 1024, 1024, 256, 32, nullptr, 3, Weo_t + (size_t)e * 1024 * 256, scr, r % I_EO1, lane); continue; } r -= I_EO;
            if (r < I_PG) { transpose_item(w_pg, 1024, 1024, 32, g_ple, 3, Wpg_t, scr, r, lane); continue; } r -= I_PG;
            transpose_item(w_pp, 1024, 256, 32, nullptr, 3, Wpp_t, scr, r, lane);
        }
        for (int e = bx * (NWAVES * 64) + tid; e < 64 * 1024 / 8; e += G * NWAVES * 64) *((u32x4*)(Win_t + (size_t)1728 * 1024) + e) = (u32x4){0u, 0u, 0u, 0u};
        { f32x4 gg[4];
#pragma unroll
          for (int j = 0; j < 4; ++j) gg[j] = *((const f32x4*)g_mix + lane + 64 * j);
          for (int m0 = gw; m0 < T_TOK; m0 += 2 * NGW) {
            f32x4 v[2][4], pv[2];
#pragma unroll
            for (int q = 0; q < 2; ++q) { const int m = m0 + q * NGW < T_TOK ? m0 + q * NGW : m0; const f32x4* xr = (const f32x4*)(x + (size_t)m * DM) + lane;
#pragma unroll
                for (int j = 0; j < 4; ++j) v[q][j] = xr[64 * j];
                pv[q] = *((const f32x4*)(p_in + (size_t)m * 256) + lane); }
#pragma unroll
            for (int q = 0; q < 2; ++q) { const int m = m0 + q * NGW; if (m >= T_TOK) break; float s = 0.f;
#pragma unroll
                for (int j = 0; j < 4; ++j) s += (v[q][j].x * v[q][j].x + v[q][j].y * v[q][j].y) + (v[q][j].z * v[q][j].z + v[q][j].w * v[q][j].w);
                const float rs = __builtin_amdgcn_rsqf(wave_sum(s) * (1.f / DM) + EPS);
                u32x2* o8 = (u32x2*)(XN + (size_t)m * DM) + lane;
#pragma unroll
                for (int j = 0; j < 4; ++j) { u32x2 w; w.x = cvt_pk_bf16(v[q][j].x * rs * gg[j].x, v[q][j].y * rs * gg[j].y); w.y = cvt_pk_bf16(v[q][j].z * rs * gg[j].z, v[q][j].w * rs * gg[j].w); o8[64 * j] = w; }
                u32x2 w; w.x = cvt_pk_bf16(pv[q].x, pv[q].y); w.y = cvt_pk_bf16(pv[q].z, pv[q].w);
                *((u32x2*)(PB + (size_t)m * 256) + lane) = w; }
          } }
        for (int e = bx * (NWAVES * 64) + tid; e < SEQ * 32; e += G * NWAVES * 64) {
            const int pos = e >> 5, i = e & 31; const float inv = powf(10000.f, -(float)(2 * i) / 64.f); const float ang = (float)pos * inv;
            float c, s; sincos_d(ang, c, s); *(f32x2*)(ROPE + (size_t)e * 2) = (f32x2){c, s};
        }
        for (int e = bx * (NWAVES * 64) + tid; e < 20 * 1024; e += G * NWAVES * 64) {
            const int j = e >> 10, k = e & 1023; WR[e] = g_ffn[k] * (j < 4 ? w_rg[k * 4 + j] : w_re[k * 16 + (j - 4)]);
        }
    }
    SEAM(0);
    if (IN(1)) {
        KP_INIT bf16_t* XN = WSP(bf16_t, WS_XN); bf16_t* Win_t = WSP(bf16_t, WS_WIN); bf16_t* PB = WSP(bf16_t, WS_PB); bf16_t* Wpp_t = WSP(bf16_t, WS_WPP); bf16_t* PP = WSP(bf16_t, WS_PP); bf16_t* QA = WSP(bf16_t, WS_QA); bf16_t* KVA = WSP(bf16_t, WS_KVA);
        bf16_t* CQ = WSP(bf16_t, WS_CQ); bf16_t* CKV = WSP(bf16_t, WS_CKV); bf16_t* KR = WSP(bf16_t, WS_KR); float* SSQ = WSP(float, WS_SSQ); float* SSKV = WSP(float, WS_SSKV); float* ROPE = WSP(float, WS_ROPE);
        { pg8::Gemm g{XN, Win_t, 1024}; pg8::StaticOrder S; S.init(T_TOK, N1, G, bx);
          pg8::EpiIn E{QA, KVA, CQ, CKV, KR, SSQ, SSKV, ROPE}; pg8::gemm_phase(lds, g, S, E); }
        if (bx >= G - 64) { pg8::Gemm g{PB, Wpp_t, 256}; pg8::StaticOrder S; S.init(T_TOK, 1024, 64, bx - (G - 64));
          pg8::EpiRows E{PP, DM, nullptr, 0.f, 1.f, 1 << 30, nullptr}; pg8::gemm_phase(lds, g, S, E); }
    }
    SEAM(1);
    if (IN(2)) { PH_IDS
        KP_INIT const float* sinks = INP(4); bf16_t* CQ = WSP(bf16_t, WS_CQ); bf16_t* CKV = WSP(bf16_t, WS_CKV); bf16_t* Wuq_t = WSP(bf16_t, WS_WUQ); bf16_t* Wukv_t = WSP(bf16_t, WS_WUKV); bf16_t* Qm = WSP(bf16_t, WS_Q); bf16_t* KVm = (bf16_t*)OUTP;
        bf16_t* QA = WSP(bf16_t, WS_QA); bf16_t* KVA = WSP(bf16_t, WS_KVA); float* SSQ = WSP(float, WS_SSQ); float* SSKV = WSP(float, WS_SSKV); float* ROPE = WSP(float, WS_ROPE);
        { pg8::Gemm g{CQ, Wuq_t, 256}; pg8::StaticOrder S; S.init(T_TOK, QW, G, bx);
          pg8::EpiRows E{Qm, QW, SSQ, 1.f / 256.f, C2MLA, 4, ROPE}; pg8::gemm_phase(lds, g, S, E); }
        { pg8::Gemm g{CKV, Wukv_t, 128}; pg8::StaticOrder S; S.init(T_TOK, KVW, G, bx);
          pg8::EpiRows E{KVm, KVW, SSKV, 1.f / 128.f, 1.f, 1 << 30, nullptr}; pg8::gemm_phase(lds, g, S, E); }
        for (int uidx = vcu; uidx < 2 * 2 * 256; uidx += G) {
            const int pblk = uidx & 255, kvh = (uidx >> 8) & 1, b = uidx >> 9;
            const int h = kvh * 8 + wave, pos0 = pblk * 32; const size_t rowb = (size_t)b * SEQ;
            const int lowk = pos0 - 127; const int j_lo = lowk > 0 ? lowk / 64 : 0, j_hi = (pos0 + 31) / 64 + 1;
            const bf16_t* qp = QA + (rowb + pos0) * DM + h * 64;
            att::attn_unit<64, 64, 64>((LAS char*)lds, qp, qp, DM, KVA + rowb * 256 + kvh * 64, 256, nullptr, 0, KVA + rowb * 256 + 128 + kvh * 64, 256,
                                       j_lo, j_hi, pos0, 128u, sinks[h] * LOG2E, 1.f, QA + (rowb + pos0) * DM + h * 64, DM);
        }
    }
    SEAM(2);
#if PROBE_ATT >= 0
    {   PH_IDS KP_INIT bf16_t* Qm = WSP(bf16_t, WS_Q); bf16_t* KVm = (bf16_t*)OUTP; bf16_t* KR = WSP(bf16_t, WS_KR); bf16_t* MG = WSP(bf16_t, WS_MG);
        t_p0 = __builtin_amdgcn_s_memrealtime();
        for (int pi = vcu; pi < 256; pi += G) {
            const int bh = pi >> 4, s = pi & 15, b = bh >> 3, h = bh & 7; const size_t rowb = (size_t)b * SEQ;
            for (int pass = 0; pass < 2; ++pass) {
                const int qb = pass == 0 ? 31 - s : s, q0 = qb * 256 + wave * 32;
                const bf16_t* q1 = Qm + (rowb + q0) * QW + h * 128; const bf16_t* q2 = Qm + (rowb + q0) * QW + 1024 + h * 64;
                att::attn_unit<192, 128, 128, PROBE_ATT>((LAS char*)lds, q1, q2, QW, KVm + rowb * KVW + h * 256, KVW, KR + rowb * 64, 64, KVm + rowb * KVW + h * 256 + 128, KVW,
                                              0, (qb + 1) * 4, q0, 1u << 30, -1e30f, 0.f, MG + (rowb + q0) * DM + h * 128, DM);
            }
        }
        GRID_BAR(); t_p1 = __builtin_amdgcn_s_memrealtime();
    }
#endif
    if (IN(3)) { PH_IDS
        KP_INIT bf16_t* Qm = WSP(bf16_t, WS_Q); bf16_t* KVm = (bf16_t*)OUTP; bf16_t* KR = WSP(bf16_t, WS_KR);
        for (int pi = vcu; pi < 256; pi += G) {
            const int bh = pi >> 4, s = pi & 15, b = bh >> 3, h = bh & 7; const size_t rowb = (size_t)b * SEQ;
            for (int pass = 0; pass < 2; ++pass) {
                const int qb = pass == 0 ? 31 - s : s, q0 = qb * 256 + wave * 32;
                const bf16_t* q1 = Qm + (rowb + q0) * QW + h * 128; const bf16_t* q2 = Qm + (rowb + q0) * QW + 1024 + h * 64;
                att::attn_unit<192, 128, 128>((LAS char*)lds, q1, q2, QW, KVm + rowb * KVW + h * 256, KVW, KR + rowb * 64, 64, KVm + rowb * KVW + h * 256 + 128, KVW,
                                              0, (qb + 1) * 4, q0, 1u << 30, -1e30f, 0.f, Qm + (rowb + q0) * QW + h * 128, QW);
            }
        }
    }
    SEAM(3);
    if (IN(4)) {
        KP_INIT bf16_t* XN = WSP(bf16_t, WS_XN); bf16_t* Wg_t = WSP(bf16_t, WS_WG); bf16_t* QA = WSP(bf16_t, WS_QA); bf16_t* Qm = WSP(bf16_t, WS_Q); bf16_t* MG = WSP(bf16_t, WS_MG);
        pg8::Gemm g{XN, Wg_t, 1024}; pg8::StaticOrder S; S.init(T_TOK, NGATE, G, bx);
        pg8::EpiGate E{QA, Qm, QW, MG}; pg8::gemm_phase(lds, g, S, E);
    }
    SEAM(4);
    if (IN(5)) {
        KP_INIT const float* x = INP(0); float* out = OUTP; bf16_t* MG = WSP(bf16_t, WS_MG); bf16_t* Wout_t = WSP(bf16_t, WS_WOUT); bf16_t* HB = WSP(bf16_t, WS_HB);
        pg8::Gemm g{MG, Wout_t, 1024}; pg8::StaticOrder S; S.init(T_TOK, 1024, G, bx);
        pg8::EpiRes E{x, out, HB}; pg8::gemm_phase(lds, g, S, E);
    }
    SEAM(5);
    if (IN(6)) { PH_IDS
        KP_INIT const float* b_rg = INP(12); const float* b_re = INP(14); float* out = OUTP; float* WR = WSP(float, WS_WR); int* TOKE = WSP(int, WS_TOKE); int* TOKPOS = WSP(int, WS_TOKPOS);
        int* VTOK = WSP(int, WS_VTOK); float* VCW = WSP(float, WS_VCW); float* VR = WSP(float, WS_VR);
        LAS float* wl = (LAS float*)lds;
        for (int i = tid; i < 20 * 256; i += NWAVES * 64) ((LAS f32x4*)wl)[i] = ((const f32x4*)WR)[i];
        __syncthreads();
        f32x4 vn[4];
        if (gw < T_TOK) { const f32x4* hr = (const f32x4*)(out + (size_t)gw * DM) + lane;
#pragma unroll
            for (int j = 0; j < 4; ++j) vn[j] = hr[64 * j]; }
        for (int m = gw; m < T_TOK; m += NGW) {
            f32x4 v[4]; float s = 0.f;
#pragma unroll
            for (int j = 0; j < 4; ++j) { v[j] = vn[j]; s += (v[j].x * v[j].x + v[j].y * v[j].y) + (v[j].z * v[j].z + v[j].w * v[j].w); }
            { const int mn = m + NGW < T_TOK ? m + NGW : m; const f32x4* hr = (const f32x4*)(out + (size_t)mn * DM) + lane;
#pragma unroll
              for (int j = 0; j < 4; ++j) vn[j] = hr[64 * j]; }
            const float r2 = __builtin_amdgcn_rsqf(wave_sum(s) * (1.f / DM) + EPS);
            float lg[20];
#pragma unroll
            for (int c = 0; c < 20; ++c) { float d = 0.f;
#pragma unroll
                for (int j = 0; j < 4; ++j) { const f32x4 w = ((const LAS f32x4*)wl)[c * 256 + 64 * j + lane]; d += (v[j].x * w.x + v[j].y * w.y) + (v[j].z * w.z + v[j].w * w.w); }
                lg[c] = wave_sum(d) * r2; asm volatile("" ::: "memory"); }
#pragma unroll
            for (int c = 0; c < 4; ++c) lg[c] += b_rg[c];
#pragma unroll
            for (int c = 0; c < 16; ++c) lg[4 + c] += b_re[c];
            int gi = 0; float gm = lg[0];
#pragma unroll
            for (int c = 1; c < 4; ++c) if (lg[c] > gm) { gm = lg[c]; gi = c; }
            float gs = 0.f;
#pragma unroll
            for (int c = 0; c < 4; ++c) gs += __expf(lg[c] - gm);
            const float g_w = 1.f / gs;
            float es[4];
#pragma unroll
            for (int k = 0; k < 4; ++k) es[k] = gi == 0 ? lg[4 + k] : gi == 1 ? lg[8 + k] : gi == 2 ? lg[12 + k] : lg[16 + k];
            int i0 = 0; float e0 = es[0];
#pragma unroll
            for (int k = 1; k < 4; ++k) if (es[k] > e0) { e0 = es[k]; i0 = k; }
            int i1 = -1; float e1 = -__builtin_inff();
#pragma unroll
            for (int k = 0; k < 4; ++k) if (k != i0 && es[k] > e1) { e1 = es[k]; i1 = k; }
            const float t1 = __expf(e1 - e0), w0 = 1.f / (1.f + t1), w1 = t1 * w0;
            if (lane == 0) {
                const int ex0 = gi * 4 + i0, ex1 = gi * 4 + i1;
                const int p0 = (int)__hip_atomic_fetch_add(ctl + CW_CNT + 64 * ex0, 1u, RLX_AGENT), p1 = (int)__hip_atomic_fetch_add(ctl + CW_CNT + 64 * ex1, 1u, RLX_AGENT);
                TOKE[m] = ex0 | (ex1 << 8); TOKPOS[2 * m] = p0; TOKPOS[2 * m + 1] = p1;
                VTOK[ex0 * 16384 + p0] = m; VTOK[ex1 * 16384 + p1] = m; VCW[ex0 * 16384 + p0] = w0 * g_w; VCW[ex1 * 16384 + p1] = w1 * g_w; VR[ex0 * 16384 + p0] = r2; VR[ex1 * 16384 + p1] = r2;
            }
        }
    }
    SEAM(6);
    if (IN(8)) {
        KP_INIT bf16_t* HB = WSP(bf16_t, WS_HB); bf16_t* Wei_t = WSP(bf16_t, WS_WEI); bf16_t* ACT = WSP(bf16_t, WS_ACT); int* VTOK = WSP(int, WS_VTOK); float* VCW = WSP(float, WS_VCW); float* VR = WSP(float, WS_VR);
        pg8::Gemm g{HB, Wei_t, 1024}; pg8::GroupedOrder S; S.init((const unsigned*)(ctl + CW_CNT), 2, G, bx);
        pg8::EpiMoeIn E{VR, VCW, ACT}; pg8::gemm_phase<true>(lds, g, S, E, VTOK);
    }
    SEAM(8);
    if (IN(9)) {
        KP_INIT bf16_t* ACT = WSP(bf16_t, WS_ACT); bf16_t* Weo_t = WSP(bf16_t, WS_WEO); bf16_t* Y = WSP(bf16_t, WS_Y);
        pg8::Gemm g{ACT, Weo_t, 256}; pg8::GroupedOrder S; S.init((const unsigned*)(ctl + CW_CNT), 4, G, bx);
        pg8::EpiRows E{Y, DM, nullptr, 0.f, 1.f, 1 << 30, nullptr}; pg8::gemm_phase(lds, g, S, E);
    }
    SEAM(9);
    if (IN(10)) { PH_IDS
        KP_INIT float* out = OUTP; bf16_t* Y = WSP(bf16_t, WS_Y); bf16_t* HB = WSP(bf16_t, WS_HB); int* TOKE = WSP(int, WS_TOKE); int* TOKPOS = WSP(int, WS_TOKPOS); float* SS2 = WSP(float, WS_SS2);
        int off[NEXP]; { int tot = 0;
#pragma unroll
          for (int e = 0; e < NEXP; ++e) { const int c = (int)__builtin_amdgcn_readfirstlane(__hip_atomic_load(ctl + CW_CNT + 64 * e, RLX_AGENT)); off[e] = tot; tot += (c + 255) >> 8; } }
        for (int m = gw; m < T_TOK; m += NGW) {
            const int ee = __builtin_amdgcn_readfirstlane(TOKE[m]), ex0 = ee & 255, ex1 = ee >> 8; int o0 = 0, o1 = 0;
#pragma unroll
            for (int e = 0; e < NEXP; ++e) { o0 = (e == ex0) ? off[e] : o0; o1 = (e == ex1) ? off[e] : o1; }
            const int s0 = o0 * 256 + __builtin_amdgcn_readfirstlane(TOKPOS[2 * m]), s1 = o1 * 256 + __builtin_amdgcn_readfirstlane(TOKPOS[2 * m + 1]);
            f32x4* hr = (f32x4*)(out + (size_t)m * DM) + lane; const u32x2* y0 = (const u32x2*)(Y + (size_t)s0 * DM) + lane; const u32x2* y1 = (const u32x2*)(Y + (size_t)s1 * DM) + lane;
            u32x2* hb = (u32x2*)(HB + (size_t)m * DM) + lane; float s = 0.f;
#pragma unroll
            for (int j = 0; j < 4; ++j) { f32x4 v = hr[64 * j]; const u32x2 a = y0[64 * j], b2 = y1[64 * j];
                v.x += bf_lo(a.x) + bf_lo(b2.x); v.y += bf_hi(a.x) + bf_hi(b2.x); v.z += bf_lo(a.y) + bf_lo(b2.y); v.w += bf_hi(a.y) + bf_hi(b2.y);
                s += (v.x * v.x + v.y * v.y) + (v.z * v.z + v.w * v.w); hr[64 * j] = v;
                u32x2 w; w.x = cvt_pk_bf16(v.x, v.y); w.y = cvt_pk_bf16(v.z, v.w); hb[64 * j] = w; }
            s = wave_sum(s); if (lane == 0) SS2[m] = s;
        }
    }
    SEAM(10);
    if (IN(11)) {
        KP_INIT float* out = OUTP; bf16_t* HB = WSP(bf16_t, WS_HB); bf16_t* Wpg_t = WSP(bf16_t, WS_WPG); bf16_t* PP = WSP(bf16_t, WS_PP); float* SS2 = WSP(float, WS_SS2);
        pg8::Gemm g{HB, Wpg_t, 1024}; pg8::StaticOrder S; S.init(T_TOK, 1024, G, bx);
        pg8::EpiPle E{out, PP, SS2}; pg8::gemm_phase(lds, g, S, E);
    }
    SEAM(11);
    if (IN(12)) { PH_IDS
        KP_INIT float* out = OUTP; const float* g_fin = INP(20);
        for (int m = gw; m < T_TOK; m += NGW) {
            f32x4* hr = (f32x4*)(out + (size_t)m * DM) + lane; f32x4 v[4]; float s = 0.f;
#pragma unroll
            for (int j = 0; j < 4; ++j) { v[j] = hr[64 * j]; s += (v[j].x * v[j].x + v[j].y * v[j].y) + (v[j].z * v[j].z + v[j].w * v[j].w); }
            const float rs = __builtin_amdgcn_rsqf(wave_sum(s) * (1.f / DM) + EPS);
#pragma unroll
            for (int j = 0; j < 4; ++j) { const f32x4 gg = *((const f32x4*)g_fin + lane + 64 * j); hr[64 * j] = (f32x4){v[j].x * rs * gg.x, v[j].y * rs * gg.y, v[j].z * rs * gg.z, v[j].w * rs * gg.w}; }
        }
    }
    if (PROBE_LO >= 0 || PROBE_ATT >= 0) { if (PROBE_HI == NPHASE - 1) t_p1 = __builtin_amdgcn_s_memrealtime();
        if (bx == 0) { const unsigned long long te = __builtin_amdgcn_s_memrealtime(), d = (t_p1 - t_p0) * PROBE_MUL; while (__builtin_amdgcn_s_memrealtime() - te < d) __builtin_amdgcn_s_sleep(8); } }
#undef IN
#undef SEAM
#undef GRID_BAR
}

extern "C" void kernel_launch(void* const* d_in, const int* in_sizes, int n_in, void* d_out, int out_size, void* d_ws, size_t ws_size, hipStream_t stream) {
    static int grid = 0;
    if (grid == 0) {
        if (n_in != 21 || in_sizes[0] != T_TOK * DM || out_size != T_TOK * DM || ws_size < WS_END) { fprintf(stderr, "kernel_launch: unexpected shapes (n_in %d, in0 %d, out %d, ws %zu)\n", n_in, n_in > 0 ? in_sizes[0] : -1, out_size, ws_size); grid = -1; return; }
        int dev = 0, cus = 0, per_cu = 0;
        if (hipGetDevice(&dev) != hipSuccess || hipDeviceGetAttribute(&cus, hipDeviceAttributeMultiprocessorCount, dev) != hipSuccess) { grid = -1; return; }
        if (hipFuncSetAttribute((const void*)mk_fwd, hipFuncAttributeMaxDynamicSharedMemorySize, LDS_BYTES) != hipSuccess) { fprintf(stderr, "kernel_launch: hipFuncSetAttribute failed\n"); grid = -1; return; }
        if (hipOccupancyMaxActiveBlocksPerMultiprocessor(&per_cu, (const void*)mk_fwd, NWAVES * 64, LDS_BYTES) != hipSuccess || per_cu < 1) { fprintf(stderr, "kernel_launch: occupancy query says %d blocks per CU\n", per_cu); (void)hipGetLastError(); grid = -1; return; }
        grid = cus;
    }
    if (grid < 0) return;
    (void)hipMemsetAsync((char*)d_ws + WS_CTL, 0, CTL_ZERO_BYTES, stream);
    Args a{};
    for (int i = 0; i < 21; ++i) a.in[i] = (const float*)d_in[i];
    a.out = (float*)d_out; a.ws = (unsigned char*)d_ws;
#if MK_ONE_LAUNCH
    a.ph_lo = 0; a.ph_hi = NPHASE;
    hipLaunchKernelGGL(mk_fwd, dim3(grid), dim3(NWAVES * 64), LDS_BYTES, stream, a);
#else
    for (int ph = 0; ph < NPHASE; ++ph) { a.ph_lo = ph; a.ph_hi = ph + 1; hipLaunchKernelGGL(mk_fwd, dim3(grid), dim3(NWAVES * 64), LDS_BYTES, stream, a); }
#endif
}
```

```cpp
#include <hip/hip_runtime.h>
#include <hip/hip_bf16.h>
#include <cstdio>
#include <cstdint>

#ifndef MK_ONE_LAUNCH
#define MK_ONE_LAUNCH 1
#endif

#ifndef PROBE_LO
#define PROBE_LO -1
#define PROBE_HI -1
#endif
#ifndef PROBE_MUL
#define PROBE_MUL 3
#endif
#ifndef PROBE_ATT
#define PROBE_ATT -1
#endif
#define LAS __attribute__((address_space(3)))
#define GAS __attribute__((address_space(1)))
typedef unsigned short bf16_t;
typedef short bf16x8 __attribute__((ext_vector_type(8)));
typedef short s16x4 __attribute__((ext_vector_type(4)));
typedef float f32x2 __attribute__((ext_vector_type(2)));
typedef float f32x4 __attribute__((ext_vector_type(4)));
typedef float f32x16 __attribute__((ext_vector_type(16)));
typedef unsigned u32x2 __attribute__((ext_vector_type(2)));
typedef unsigned u32x4 __attribute__((ext_vector_type(4)));

constexpr int T_TOK = 16384, SEQ = 8192, DM = 1024;
constexpr int N1 = 1792;
constexpr int NGATE = 2048;
constexpr int QW = 1536, KVW = 2048;
constexpr int NEXP = 16, DEXP = 256;
constexpr int MAXTILES = 144, MAXSLOTS = MAXTILES * 256;
constexpr float EPS = 1e-6f;
constexpr float LOG2E = 1.4426950408889634f;
constexpr float C2SWA = 0.125f * LOG2E;
constexpr float C2MLA = 0.07216878364870322f * LOG2E;

__device__ __forceinline__ unsigned cvt_pk_bf16(float lo, float hi) { unsigned r; asm volatile("v_cvt_pk_bf16_f32 %0, %1, %2" : "=v"(r) : "v"(lo), "v"(hi)); return r; }
__device__ __forceinline__ float bf_lo(unsigned w) { return __uint_as_float(w << 16); }
__device__ __forceinline__ float bf_hi(unsigned w) { return __uint_as_float(w & 0xffff0000u); }
__device__ __forceinline__ float fsigmoid(float x) { return __builtin_amdgcn_rcpf(1.f + __builtin_amdgcn_exp2f(-x * LOG2E)); }
__device__ __forceinline__ int opaque_tid() { int t = threadIdx.x; asm volatile("" : "+v"(t)); return t; }
__device__ __forceinline__ float dpp_add(float v, int ctrl_sel) {
    const int b = __builtin_bit_cast(int, v); int r;
    switch (ctrl_sel) { case 0: r = __builtin_amdgcn_update_dpp(0, b, 0xB1, 0xf, 0xf, true); break;
                        case 1: r = __builtin_amdgcn_update_dpp(0, b, 0x4E, 0xf, 0xf, true); break;
                        case 2: r = __builtin_amdgcn_update_dpp(0, b, 0x141, 0xf, 0xf, true); break;
                        default: r = __builtin_amdgcn_update_dpp(0, b, 0x140, 0xf, 0xf, true); break; }
    return v + __builtin_bit_cast(float, r);
}
__device__ __forceinline__ float wave_sum(float v) {
    v = dpp_add(v, 0); v = dpp_add(v, 1); v = dpp_add(v, 2); v = dpp_add(v, 3);
    { auto rr = __builtin_amdgcn_permlane16_swap(__float_as_uint(v), __float_as_uint(v), false, false); v = __uint_as_float(rr[0]) + __uint_as_float(rr[1]); }
    { auto rr = __builtin_amdgcn_permlane32_swap(__float_as_uint(v), __float_as_uint(v), false, false); v = __uint_as_float(rr[0]) + __uint_as_float(rr[1]); }
    return v;
}

namespace pg8 {
constexpr int BM = 256, BK = 64, HALF = 128, HTB = HALF * BK * 2, STAGE_BYTES = 8 * HTB, NXCD = 8, WGM = 8;
__host__ __device__ __forceinline__ int lds_byte(int r, int c) { const int st = (r >> 4) * 2 + (c >> 5), rr = r & 15, cc = c & 31, ob = rr * 64 + cc * 2; return st * 1024 + (ob ^ (((ob >> 9) & 1) << 5)); }
__host__ __device__ __forceinline__ void stage_rc(int b, int& R, int& C) { const int st = b / 1024, sb = b % 1024, swz = sb ^ (((sb >> 9) & 1) << 5); R = (st >> 1) * 16 + swz / 64; C = (st & 1) * 32 + (swz % 64) / 2; }
__host__ __device__ __forceinline__ int perm32(int rho) { const int n = rho >> 4, i = rho & 15; return 8 * (i >> 2) + 4 * n + (i & 3); }

struct Unit { int pm, pn, pb, e, lt, cnt; };
struct Gemm { const bf16_t* A; const bf16_t* Bt; int K; };

struct StaticOrder {
    int nM, nN, nwg, G, c;
    __device__ __forceinline__ void init(int M, int N, int G_, int c_) { nM = M / BM; nN = N / BM; nwg = nM * nN; G = G_; c = c_; }
    __device__ __forceinline__ bool next(int i, Unit& u) const {
        const long L = (long)i * G + c; if (L >= nwg) return false;
        int wgid = (int)L; { const int q = nwg / NXCD, r = nwg % NXCD, xcd = wgid % NXCD, off = wgid / NXCD; wgid = (xcd < r ? xcd * (q + 1) : r * (q + 1) + (xcd - r) * q) + off; }
        const int nig = WGM * nN, gid = wgid / nig, fm = gid * WGM, gsz = (nM - fm) < WGM ? (nM - fm) : WGM;
        u.pm = fm + ((wgid % nig) % gsz); u.pn = (wgid % nig) / gsz; u.pb = u.pn; u.e = 0; u.lt = 0; u.cnt = 0; return true;
    }
};
struct GroupedOrder {
    int cnt[NEXP]; int npn, G, c;
    __device__ __forceinline__ void init(const unsigned* cntw, int npn_, int G_, int c_) { npn = npn_; G = G_; c = c_;
        unsigned t[NEXP];
#pragma unroll
        for (int k = 0; k < NEXP; ++k) t[k] = __hip_atomic_load(cntw + 64 * k, __ATOMIC_RELAXED, __HIP_MEMORY_SCOPE_AGENT);
#pragma unroll
        for (int k = 0; k < NEXP; ++k) cnt[k] = (int)__builtin_amdgcn_readfirstlane(t[k]); }
    __device__ __forceinline__ bool next(int i, Unit& u) const {
        const int L = i * G + c, pm = L / npn; int acc = 0, e = -1, lt = 0, ce = 0;
#pragma unroll
        for (int k = 0; k < NEXP; ++k) { const int nt = (cnt[k] + 255) >> 8; if (pm >= acc && pm < acc + nt) { e = k; lt = pm - acc; ce = cnt[k]; } acc += nt; }
        if (e < 0) return false;
        u.pm = pm; u.pn = L - pm * npn; u.pb = e * npn + u.pn; u.e = e; u.lt = lt; u.cnt = ce; return true;
    }
};

typedef f32x4 Acc[2][2][4][2];

template <bool GATHER = false, class Epi, class Sched>
__device__ __forceinline__ void gemm_phase(LAS unsigned char* lds, const Gemm g, const Sched& S, const Epi& E, const int* vtok = nullptr) {
    const int tid = opaque_tid(), wid = __builtin_amdgcn_readfirstlane(tid >> 6), lane = tid & 63, wr = wid >> 2, wc = wid & 3, fr = lane & 15, fq = lane >> 4;
    const int K = g.K, nt = K / BK;
    unsigned voffA[2], voffB[2], gC[2]; int gR[2];
    unsigned voffc[2][2], voffn[2][2];
#pragma unroll
    for (int i = 0; i < 2; ++i) { int R, C; stage_rc(tid * 16 + i * 8192, R, C); const int Rb = (R & ~31) + perm32(R & 31);
        voffA[i] = (unsigned)(R * K + C) * 2u; voffB[i] = (unsigned)(Rb * K + C) * 2u; gR[i] = R; gC[i] = (unsigned)C * 2u; }
    const size_t kstep = (size_t)(BK * 2);
    const size_t hstep = (size_t)HALF * K * 2;
    const size_t tstep = 2 * hstep;
    const unsigned ldsw = (unsigned)wid * 1024u;
    const int aoff = lds_byte(wr * 64 + fr, fq * 8), boff = lds_byte(wc * 32 + fr, fq * 8);
#define PG8_SA(b, h) (((b) * 2 + (h)) * HTB)
#define PG8_SB(b, h) ((4 + (b) * 2 + (h)) * HTB)
#define PG8_STAGE(bufoff, gbase, voff) do { _Pragma("unroll") for (int _i = 0; _i < 2; ++_i) \
        __builtin_amdgcn_global_load_lds((const unsigned*)((const char*)(gbase) + (voff)[_i]), (LAS unsigned*)(lds + (bufoff) + ldsw + _i * 8192), 16, 0, 0); } while (0)
#define PG8_GOFFS(dst, un) do { _Pragma("unroll") for (int h_ = 0; h_ < 2; ++h_) _Pragma("unroll") for (int i_ = 0; i_ < 2; ++i_) { \
        int pos_ = (un).lt * 256 + h_ * 128 + gR[i_]; pos_ = pos_ < (un).cnt ? pos_ : 0; dst[h_][i_] = (unsigned)vtok[(un).e * 16384 + pos_] * (unsigned)(K * 2) + gC[i_]; } } while (0)
#define PG8_STAGE_A(bufoff, h, kt, nx) do { if constexpr (GATHER) { unsigned vo_[2]; vo_[0] = (nx) ? voffn[h][0] : voffc[h][0]; vo_[1] = (nx) ? voffn[h][1] : voffc[h][1]; \
            PG8_STAGE(bufoff, (const char*)g.A + (size_t)(kt) * kstep, vo_); } \
        else { PG8_STAGE(bufoff, ((nx) ? nA : cA) + (size_t)(kt) * kstep + (h) * hstep, voffA); } } while (0)
#define PG8_LDA(dst, b, h) do { _Pragma("unroll") for (int m = 0; m < 4; ++m) _Pragma("unroll") for (int k = 0; k < 2; ++k) dst[m][k] = *(const LAS bf16x8*)(lds + PG8_SA(b, h) + aoff + m * 2048 + k * 1024); } while (0)
#define PG8_LDB(dst, b, h) do { _Pragma("unroll") for (int n = 0; n < 2; ++n) _Pragma("unroll") for (int k = 0; k < 2; ++k) dst[n][k] = *(const LAS bf16x8*)(lds + PG8_SB(b, h) + boff + n * 2048 + k * 1024); } while (0)
#define PG8_MMA(ai, bj, At, Bt) do { __builtin_amdgcn_s_setprio(1); _Pragma("unroll") for (int m = 0; m < 4; ++m) _Pragma("unroll") for (int n = 0; n < 2; ++n) _Pragma("unroll") for (int k = 0; k < 2; ++k) \
        acc[ai][bj][m][n] = __builtin_amdgcn_mfma_f32_16x16x32_bf16(Bt[n][k], At[m][k], acc[ai][bj][m][n], 0, 0, 0); __builtin_amdgcn_s_setprio(0); } while (0)
#define PG8_WAIT_V(n) asm volatile("s_waitcnt vmcnt(" #n ")" ::: "memory")
#define PG8_WAIT_L(n) asm volatile("s_waitcnt lgkmcnt(" #n ")" ::: "memory")
#define PG8_BAR __builtin_amdgcn_s_barrier()
#define PG8_SCHED __builtin_amdgcn_sched_barrier(0)
    Unit cur, nxt; int ui = 0;
    if (!S.next(0, cur)) return;
    Acc acc;
#pragma unroll
    for (int a = 0; a < 2; ++a)
#pragma unroll
        for (int b = 0; b < 2; ++b)
#pragma unroll
            for (int m = 0; m < 4; ++m)
#pragma unroll
                for (int n = 0; n < 2; ++n) acc[a][b][m][n] = (f32x4){0.f, 0.f, 0.f, 0.f};
    bf16x8 At[4][2], B0[2][2], B1[2][2];
    const char* cA = (const char*)g.A + (size_t)cur.pm * tstep; const char* cB = (const char*)g.Bt + (size_t)cur.pb * tstep; const char* nA = cA;
    if constexpr (GATHER) { PG8_GOFFS(voffc, cur); asm volatile("s_waitcnt vmcnt(0)" ::: "memory"); }
    PG8_STAGE(PG8_SB(0, 0), cB, voffB); PG8_STAGE(PG8_SB(0, 1), cB + hstep, voffB); PG8_STAGE_A(PG8_SA(0, 0), 0, 0, false); PG8_STAGE_A(PG8_SA(0, 1), 1, 0, false);
    if (wr == 1) PG8_BAR;
    PG8_WAIT_V(2); PG8_BAR;
    PG8_STAGE(PG8_SB(1, 0), cB + kstep, voffB); PG8_STAGE_A(PG8_SA(1, 0), 0, 1, false); PG8_STAGE(PG8_SB(1, 1), cB + hstep + kstep, voffB);
    PG8_WAIT_V(6); PG8_BAR;
    for (;;) {
        const bool has_next = S.next(ui + 1, nxt);
        nA = has_next ? (const char*)g.A + (size_t)nxt.pm * tstep : cA; const char* nB = has_next ? (const char*)g.Bt + (size_t)nxt.pb * tstep : cB;
        if constexpr (GATHER) { if (has_next) PG8_GOFFS(voffn, nxt); else { voffn[0][0] = voffc[0][0]; voffn[0][1] = voffc[0][1]; voffn[1][0] = voffc[1][0]; voffn[1][1] = voffc[1][1]; }
            asm volatile("s_waitcnt vmcnt(0)" ::: "memory"); }
        for (int t = 0; t < nt; t += 2) {
            const bool last = (t == nt - 2);
            const int k2 = last ? 0 : t + 2, k3 = k2 + 1;
            const char* b2 = last ? nB : cB + (size_t)(t + 2) * kstep; const char* b3 = b2 + kstep;
            PG8_LDB(B0, 0, 0); PG8_LDB(B1, 0, 1); PG8_SCHED; PG8_LDA(At, 0, 0); PG8_STAGE_A(PG8_SA(1, 1), 1, t + 1, false);
            PG8_WAIT_V(8); PG8_WAIT_L(0); PG8_BAR; PG8_MMA(0, 0, At, B0); PG8_MMA(0, 1, At, B1); PG8_BAR; PG8_SCHED;
            PG8_LDA(At, 0, 1); PG8_STAGE(PG8_SB(0, 0), b2, voffB); PG8_STAGE(PG8_SB(0, 1), b2 + hstep, voffB); PG8_STAGE_A(PG8_SA(0, 0), 0, k2, last);
            PG8_WAIT_V(8); PG8_WAIT_L(0); PG8_BAR; PG8_MMA(1, 0, At, B0); PG8_MMA(1, 1, At, B1); PG8_BAR; PG8_SCHED;
            PG8_LDB(B0, 1, 0); PG8_LDB(B1, 1, 1); PG8_SCHED; PG8_LDA(At, 1, 0); PG8_STAGE_A(PG8_SA(0, 1), 1, k2, last);
            PG8_WAIT_V(8); PG8_WAIT_L(0); PG8_BAR; PG8_MMA(0, 0, At, B0); PG8_MMA(0, 1, At, B1); PG8_BAR; PG8_SCHED;
            PG8_LDA(At, 1, 1); PG8_STAGE(PG8_SB(1, 0), b3, voffB); PG8_STAGE(PG8_SB(1, 1), b3 + hstep, voffB); PG8_STAGE_A(PG8_SA(1, 0), 0, k3, last);
            PG8_WAIT_V(8); PG8_WAIT_L(0); PG8_BAR; PG8_MMA(1, 0, At, B0); PG8_MMA(1, 1, At, B1); PG8_BAR; PG8_SCHED;
        }
        if (wr == 0) PG8_BAR;
        E(acc, cur, wr, wc, fr, fq);
        if (!has_next) break;
#pragma unroll
        for (int a = 0; a < 2; ++a)
#pragma unroll
            for (int b = 0; b < 2; ++b)
#pragma unroll
                for (int m = 0; m < 4; ++m)
#pragma unroll
                    for (int n = 0; n < 2; ++n) acc[a][b][m][n] = (f32x4){0.f, 0.f, 0.f, 0.f};
        cur = nxt; cA = nA; cB = nB; ++ui;
        if constexpr (GATHER) { voffc[0][0] = voffn[0][0]; voffc[0][1] = voffn[0][1]; voffc[1][0] = voffn[1][0]; voffc[1][1] = voffn[1][1]; }
        if (wr == 1) PG8_BAR;
    }
    PG8_WAIT_V(0);
    PG8_BAR;
#undef PG8_SA
#undef PG8_SB
#undef PG8_STAGE
#undef PG8_LDA
#undef PG8_GOFFS
#undef PG8_STAGE_A
#undef PG8_LDB
#undef PG8_MMA
#undef PG8_WAIT_V
#undef PG8_WAIT_L
#undef PG8_BAR
#undef PG8_SCHED
}

__device__ __forceinline__ u32x4 pack8(f32x4 a, f32x4 b) { u32x4 w; w.x = cvt_pk_bf16(a[0], a[1]); w.y = cvt_pk_bf16(a[2], a[3]); w.z = cvt_pk_bf16(b[0], b[1]); w.w = cvt_pk_bf16(b[2], b[3]); return w; }
__device__ __forceinline__ void rope8(f32x4& a, f32x4& b, const float* tabrow, int i0) {
    const f32x4 t0 = *(const f32x4*)(tabrow + 2 * i0), t1 = *(const f32x4*)(tabrow + 2 * i0 + 4);
    const float a0 = a[0] * t0[0] - a[1] * t0[1], a1 = a[1] * t0[0] + a[0] * t0[1];
    const float a2 = a[2] * t0[2] - a[3] * t0[3], a3 = a[3] * t0[2] + a[2] * t0[3];
    const float b0 = b[0] * t1[0] - b[1] * t1[1], b1 = b[1] * t1[0] + b[0] * t1[1];
    const float b2 = b[2] * t1[2] - b[3] * t1[3], b3 = b[3] * t1[2] + b[2] * t1[3];
    a = (f32x4){a0, a1, a2, a3}; b = (f32x4){b0, b1, b2, b3};
}
__device__ __forceinline__ float sq8(f32x4 a, f32x4 b) { return (a[0] * a[0] + a[1] * a[1]) + (a[2] * a[2] + a[3] * a[3]) + (b[0] * b[0] + b[1] * b[1]) + (b[2] * b[2] + b[3] * b[3]); }

struct EpiIn {
    bf16_t* Qa; bf16_t* KVa; bf16_t* CQ; bf16_t* CKV; bf16_t* KR; float* SSQ; float* SSKV; const float* rope;
    __device__ __forceinline__ void operator()(const Acc& acc, const Unit& u, int wr, int wc, int, int) const {
        const int lane_ = opaque_tid() & 63, fr = lane_ & 15, fq = lane_ >> 4;
        const int row0 = u.pm * BM + wr * 64 + fr, c8 = wc * 32 + 8 * fq;
#pragma unroll
        for (int ai = 0; ai < 2; ++ai)
#pragma unroll
            for (int m = 0; m < 4; ++m) {
                const int row = row0 + ai * HALF + m * 16; const float* tab = rope + (size_t)(row & (SEQ - 1)) * 64;
                if (u.pn < 4) {
#pragma unroll
                    for (int bj = 0; bj < 2; ++bj) { f32x4 a = acc[ai][bj][m][0], b = acc[ai][bj][m][1]; const int col = bj * HALF + c8;
                        rope8(a, b, tab, (col & 63) >> 1); a = a * C2SWA; b = b * C2SWA;
                        *(u32x4*)(Qa + (size_t)row * DM + u.pn * BM + col) = pack8(a, b); }
                } else if (u.pn == 4) {
                    { f32x4 a = acc[ai][0][m][0], b = acc[ai][0][m][1]; rope8(a, b, tab, (c8 & 63) >> 1); *(u32x4*)(KVa + (size_t)row * 256 + c8) = pack8(a, b); }
                    { *(u32x4*)(KVa + (size_t)row * 256 + HALF + c8) = pack8(acc[ai][1][m][0], acc[ai][1][m][1]); }
                } else if (u.pn == 5) {
                    float s = 0.f;
#pragma unroll
                    for (int bj = 0; bj < 2; ++bj) { const f32x4 a = acc[ai][bj][m][0], b = acc[ai][bj][m][1]; s += sq8(a, b);
                        *(u32x4*)(CQ + (size_t)row * 256 + bj * HALF + c8) = pack8(a, b); }
                    s += __shfl_xor(s, 16); s += __shfl_xor(s, 32);
                    if (fq == 0) SSQ[(size_t)row * 4 + wc] = s;
                } else {
                    { const f32x4 a = acc[ai][0][m][0], b = acc[ai][0][m][1]; float s = sq8(a, b);
                      *(u32x4*)(CKV + (size_t)row * 128 + c8) = pack8(a, b);
                      s += __shfl_xor(s, 16); s += __shfl_xor(s, 32);
                      if (fq == 0) SSKV[(size_t)row * 4 + wc] = s; }
                    if (wc < 2) { f32x4 a = acc[ai][1][m][0], b = acc[ai][1][m][1]; rope8(a, b, tab, c8 >> 1); *(u32x4*)(KR + (size_t)row * 64 + c8) = pack8(a, b); }
                }
            }
    }
};
struct EpiRows {
    bf16_t* O; int ldc; const float* SS; float inv_n; float mul; int rope_pn0; const float* rope;
    __device__ __forceinline__ void operator()(const Acc& acc, const Unit& u, int wr, int wc, int, int) const {
        const int lane_ = opaque_tid() & 63, fr = lane_ & 15, fq = lane_ >> 4;
        const int row0 = u.pm * BM + wr * 64 + fr, c8 = wc * 32 + 8 * fq;
#pragma unroll
        for (int ai = 0; ai < 2; ++ai)
#pragma unroll
            for (int m = 0; m < 4; ++m) {
                const int row = row0 + ai * HALF + m * 16;
                float r = mul;
                if (SS) { const f32x4 s4 = *(const f32x4*)(SS + (size_t)row * 4); r = mul * __builtin_amdgcn_rsqf(((s4[0] + s4[1]) + (s4[2] + s4[3])) * inv_n + EPS); }
#pragma unroll
                for (int bj = 0; bj < 2; ++bj) { f32x4 a = acc[ai][bj][m][0] * r, b = acc[ai][bj][m][1] * r; const int col = bj * HALF + c8;
                    if (u.pn >= rope_pn0) rope8(a, b, rope + (size_t)(row & (SEQ - 1)) * 64, (col & 63) >> 1);
                    *(u32x4*)(O + (size_t)row * ldc + u.pn * BM + col) = pack8(a, b); }
            }
    }
};
struct EpiGate {
    const bf16_t* OA; const bf16_t* OB; int ldb; bf16_t* MG;
    __device__ __forceinline__ void operator()(const Acc& acc, const Unit& u, int wr, int wc, int, int) const {
        const int lane_ = opaque_tid() & 63, fr = lane_ & 15, fq = lane_ >> 4;
        const int row0 = u.pm * BM + wr * 64 + fr, col = u.pn * HALF + wc * 32 + 8 * fq;
#pragma unroll
        for (int ai = 0; ai < 2; ++ai)
#pragma unroll
            for (int m = 0; m < 4; ++m) {
                const int row = row0 + ai * HALF + m * 16;
                const u32x4 oa = *(const u32x4*)(OA + (size_t)row * DM + col), ob = *(const u32x4*)(OB + (size_t)row * ldb + col);
                f32x4 r0, r1;
#pragma unroll
                for (int j = 0; j < 4; ++j) {
                    const float ga = fsigmoid(acc[ai][0][m][j >> 1][(j & 1) * 2]), ga1 = fsigmoid(acc[ai][0][m][j >> 1][(j & 1) * 2 + 1]);
                    const float gb = fsigmoid(acc[ai][1][m][j >> 1][(j & 1) * 2]), gb1 = fsigmoid(acc[ai][1][m][j >> 1][(j & 1) * 2 + 1]);
                    const float v0 = ga * bf_lo(oa[j]) + gb * bf_lo(ob[j]), v1 = ga1 * bf_hi(oa[j]) + gb1 * bf_hi(ob[j]);
                    if (j < 2) { r0[2 * j] = v0; r0[2 * j + 1] = v1; } else { r1[2 * (j - 2)] = v0; r1[2 * (j - 2) + 1] = v1; }
                }
                *(u32x4*)(MG + (size_t)row * DM + col) = pack8(r0, r1);
            }
    }
};
struct EpiRes {
    const float* X; float* H; bf16_t* HB;
    __device__ __forceinline__ void operator()(const Acc& acc, const Unit& u, int wr, int wc, int, int) const {
        const int lane_ = opaque_tid() & 63, fr = lane_ & 15, fq = lane_ >> 4;
        const int row0 = u.pm * BM + wr * 64 + fr, c8 = wc * 32 + 8 * fq;
#pragma unroll
        for (int ai = 0; ai < 2; ++ai)
#pragma unroll
            for (int m = 0; m < 4; ++m) {
                const int row = row0 + ai * HALF + m * 16;
#pragma unroll
                for (int bj = 0; bj < 2; ++bj) { const size_t off = (size_t)row * DM + u.pn * BM + bj * HALF + c8;
                    const f32x4 a = *(const f32x4*)(X + off) + acc[ai][bj][m][0], b = *(const f32x4*)(X + off + 4) + acc[ai][bj][m][1];
                    *(f32x4*)(H + off) = a; *(f32x4*)(H + off + 4) = b; *(u32x4*)(HB + off) = pack8(a, b); }
            }
    }
};
struct EpiMoeIn {
    const float* VR; const float* VCW; bf16_t* ACT;
    __device__ __forceinline__ void operator()(const Acc& acc, const Unit& u, int wr, int wc, int, int) const {
        const int lane_ = opaque_tid() & 63, fr = lane_ & 15, fq = lane_ >> 4;
        const int rl0 = wr * 64 + fr, col = u.pn * HALF + wc * 32 + 8 * fq;
#pragma unroll
        for (int ai = 0; ai < 2; ++ai)
#pragma unroll
            for (int m = 0; m < 4; ++m) {
                const int rl = rl0 + ai * HALF + m * 16; int pos = u.lt * 256 + rl; pos = pos < u.cnt ? pos : 0;
                const float r = VR[u.e * 16384 + pos], cw = VCW[u.e * 16384 + pos];
                f32x4 o[2];
#pragma unroll
                for (int n = 0; n < 2; ++n)
#pragma unroll
                    for (int j = 0; j < 4; ++j) { const float gt = r * acc[ai][0][m][n][j], up = r * acc[ai][1][m][n][j]; o[n][j] = gt * fsigmoid(gt) * up * cw; }
                *(u32x4*)(ACT + (size_t)(u.pm * BM + rl) * DEXP + col) = pack8(o[0], o[1]);
            }
    }
};
struct EpiPle {
    float* H; const bf16_t* PP; const float* SS2;
    __device__ __forceinline__ void operator()(const Acc& acc, const Unit& u, int wr, int wc, int, int) const {
        const int lane_ = opaque_tid() & 63, fr = lane_ & 15, fq = lane_ >> 4;
        const int row0 = u.pm * BM + wr * 64 + fr, c8 = wc * 32 + 8 * fq;
#pragma unroll
        for (int ai = 0; ai < 2; ++ai)
#pragma unroll
            for (int m = 0; m < 4; ++m) {
                const int row = row0 + ai * HALF + m * 16; const float r = __builtin_amdgcn_rsqf(SS2[row] * (1.f / DM) + EPS);
#pragma unroll
                for (int bj = 0; bj < 2; ++bj) { const size_t off = (size_t)row * DM + u.pn * BM + bj * HALF + c8;
                    const u32x4 pp = *(const u32x4*)(PP + off); f32x4 a = *(const f32x4*)(H + off), b = *(const f32x4*)(H + off + 4);
                    const f32x4 g0 = acc[ai][bj][m][0] * r, g1 = acc[ai][bj][m][1] * r;
                    a[0] += fsigmoid(g0[0]) * bf_lo(pp[0]); a[1] += fsigmoid(g0[1]) * bf_hi(pp[0]); a[2] += fsigmoid(g0[2]) * bf_lo(pp[1]); a[3] += fsigmoid(g0[3]) * bf_hi(pp[1]);
                    b[0] += fsigmoid(g1[0]) * bf_lo(pp[2]); b[1] += fsigmoid(g1[1]) * bf_hi(pp[2]); b[2] += fsigmoid(g1[2]) * bf_lo(pp[3]); b[3] += fsigmoid(g1[3]) * bf_hi(pp[3]);
                    *(f32x4*)(H + off) = a; *(f32x4*)(H + off + 4) = b; }
            }
    }
};
}

namespace att {
__device__ __forceinline__ int v_st(int k, int c) { const int kk = (k & ~0xC) | ((k & 4) << 1) | ((k & 8) >> 1); return ((kk >> 3) * 4 + (c >> 5)) * 512 + ((kk & 7) * 32 + (c & 31)) * 2; }
__device__ __forceinline__ int v_rd_base(int lane) { return ((lane & 3) << 3) | (((lane >> 2) & 3) << 6) | (((lane >> 4) & 1) << 5) | (((lane >> 5) & 1) << 8); }
__device__ __forceinline__ int crow(int r, int hi) { return (r & 3) + 8 * (r >> 2) + 4 * hi; }
typedef short v4i16_t __attribute__((ext_vector_type(4)));
__device__ __forceinline__ s16x4 vtr(const LAS char* p) { return __builtin_bit_cast(s16x4, __builtin_amdgcn_ds_read_tr16_b64_v4i16((LAS v4i16_t*)p)); }
__device__ __forceinline__ void mask_tile(f32x16& p0, f32x16& p1, int dq, unsigned W) {
    const float NEG = -__builtin_inff();
#pragma unroll
    for (int r = 0; r < 16; ++r) {
        const int c = (r & 3) + 8 * (r >> 2);
        if ((unsigned)(dq - c) >= W) p0[r] = NEG;
        if ((unsigned)(dq - c - 32) >= W) p1[r] = NEG;
    }
}
constexpr float THR = 10.f;
template <int DQK, int DV> struct Geo { static constexpr int KROW = DQK * 2 + 16, KBUF = 64 * KROW, VBUF = 16384, LDS_V = 2 * KBUF, LDS_S = LDS_V + 2 * VBUF, LDS_BYTES = LDS_S + 8 * 256; };

template <int DQK, int DV, int K1W, int VAR = 0>
__device__ __forceinline__ void attn_unit(LAS char* lds, const bf16_t* q1, const bf16_t* q2, int QP,
                                          const bf16_t* K1, int K1P, const bf16_t* K2, int K2P, const bf16_t* Vp, int VP,
                                          int j_lo, int j_hi, int qlo, unsigned W, float m0, float l0, bf16_t* ow, int OP) {
    typedef Geo<DQK, DV> G;
    constexpr int NQF = DQK / 16, ND0 = DV / 32, K1C = K1W / 8, K2C = (DQK - K1W) / 8, VC = DV / 8;
    constexpr int NK1 = (64 * K1C) / 512, NK2 = (64 * K2C + 511) / 512, NV = (64 * VC) / 512;
    static_assert(NK1 >= 1 && NK1 <= 2 && NK2 <= 1 && NV >= 1 && NV <= 2, "staging geometry");
    const int tid = opaque_tid(), lane = tid & 63, r32 = lane & 31, hi = lane >> 5; const int wid = __builtin_amdgcn_readfirstlane(tid >> 6);
    LAS float* wsf = (LAS float*)(lds + G::LDS_S) + wid * 64;
    bf16x8 qr[NQF];
#pragma unroll
    for (int d0 = 0; d0 < NQF; ++d0) {
        if (d0 * 16 < K1W) qr[d0] = *(const bf16x8*)(q1 + (size_t)r32 * QP + d0 * 16 + hi * 8);
        else qr[d0] = *(const bf16x8*)(q2 + (size_t)r32 * QP + (d0 * 16 - K1W) + hi * 8);
    }
    const int k1r = tid / K1C, k1c = tid % K1C;
    const int k2r = K2C ? tid / (K2C ? K2C : 1) : 0, k2c = K2C ? tid % (K2C ? K2C : 1) : 0;
    const int vr = tid / VC, vc = tid % VC;
    bf16x8 sk1[NK1], sk2[NK2 ? NK2 : 1], sv[NV];
#define ATT_LOAD(kb) do { \
        _Pragma("unroll") for (int i = 0; i < NK1; ++i) sk1[i] = *(const bf16x8*)(K1 + (size_t)((kb) + k1r + i * (512 / K1C)) * K1P + k1c * 8); \
        if (NK2) sk2[0] = *(const bf16x8*)(K2 + (size_t)((kb) + k2r) * K2P + k2c * 8); \
        _Pragma("unroll") for (int i = 0; i < NV; ++i) sv[i] = *(const bf16x8*)(Vp + (size_t)((kb) + vr + i * (512 / VC)) * VP + vc * 8); } while (0)
#define ATT_WRITE(buf) do { \
        _Pragma("unroll") for (int i = 0; i < NK1; ++i) *(LAS bf16x8*)(lds + (buf) * G::KBUF + (k1r + i * (512 / K1C)) * G::KROW + k1c * 16) = sk1[i]; \
        if (NK2) *(LAS bf16x8*)(lds + (buf) * G::KBUF + k2r * G::KROW + (K1C + k2c) * 16) = sk2[0]; \
        _Pragma("unroll") for (int i = 0; i < NV; ++i) *(LAS bf16x8*)(lds + G::LDS_V + (buf) * G::VBUF + v_st(vr + i * (512 / VC), vc * 8)) = sv[i]; } while (0)
    float m_reg = m0, l_reg = l0;
    f32x16 o[ND0];
#pragma unroll
    for (int d = 0; d < ND0; ++d) o[d] = f32x16{};
    const int qm = qlo + r32 - 4 * hi;
    const int NT = j_hi - j_lo;
    ATT_LOAD(j_lo * 64);
    ATT_WRITE(0);
    __syncthreads();
#pragma unroll
    for (int d0 = 0; d0 < NQF; ++d0) asm volatile("" : "+v"(qr[d0]));
    const LAS char* kp0 = lds + r32 * G::KROW + hi * 16;
    const LAS char* vp0 = lds + G::LDS_V + v_rd_base(lane);
    for (int t = 0; t < NT; ++t) {
        const int buf = t & 1, kb = (j_lo + t) * 64;
        if (VAR != 3 && t + 1 < NT) ATT_LOAD(kb + 64);
        f32x16 p0 = f32x16{}, p1 = f32x16{};
        if (VAR != 5) { const LAS char* kp = kp0 + buf * G::KBUF;
#pragma unroll
          for (int d0 = 0; d0 < NQF; ++d0) {
              const bf16x8 b0 = *(const LAS bf16x8*)(kp + d0 * 32), b1 = *(const LAS bf16x8*)(kp + 32 * G::KROW + d0 * 32);
              p0 = __builtin_amdgcn_mfma_f32_32x32x16_bf16(b0, qr[d0], p0, 0, 0, 0);
              p1 = __builtin_amdgcn_mfma_f32_32x32x16_bf16(b1, qr[d0], p1, 0, 0, 0); } }
        if (kb + 63 > qlo || (long)kb <= (long)qlo + 31 - (long)W) mask_tile(p0, p1, qm - kb, W);
        float alpha = 1.f;
        if (VAR != 2) {
        float pmax = p0[0];
#pragma unroll
        for (int r = 1; r < 16; ++r) pmax = fmaxf(pmax, p0[r]);
#pragma unroll
        for (int r = 0; r < 16; ++r) pmax = fmaxf(pmax, p1[r]);
        { auto rr = __builtin_amdgcn_permlane32_swap(__float_as_uint(pmax), __float_as_uint(pmax), false, false);
          pmax = fmaxf(__uint_as_float(rr[0]), __uint_as_float(rr[1])); }
        if (!__all(pmax - m_reg <= THR)) {
            const float mn = fmaxf(m_reg, pmax); alpha = __builtin_amdgcn_exp2f(m_reg - mn); m_reg = mn;
            if (hi == 0) wsf[r32] = alpha;
#pragma unroll
            for (int d = 0; d < ND0; ++d)
#pragma unroll
                for (int r = 0; r < 16; ++r) o[d][r] *= wsf[crow(r, hi)];
        }
        float ps = 0.f;
#pragma unroll
        for (int r = 0; r < 16; ++r) { p0[r] = (VAR == 1) ? (p0[r] - m_reg) : __builtin_amdgcn_exp2f(p0[r] - m_reg); ps += p0[r]; }
#pragma unroll
        for (int r = 0; r < 16; ++r) { p1[r] = (VAR == 1) ? (p1[r] - m_reg) : __builtin_amdgcn_exp2f(p1[r] - m_reg); ps += p1[r]; }
        { auto rr = __builtin_amdgcn_permlane32_swap(__float_as_uint(ps), __float_as_uint(ps), false, false);
          ps = __uint_as_float(rr[0]) + __uint_as_float(rr[1]); }
        l_reg = l_reg * alpha + ps;
        }
        bf16x8 pa0, pa1, pa2, pa3;
#define PK4(P, B_, OUT) do { unsigned a0 = cvt_pk_bf16(P[B_+0], P[B_+1]), a1 = cvt_pk_bf16(P[B_+2], P[B_+3]); \
        unsigned b0_ = cvt_pk_bf16(P[B_+4], P[B_+5]), b1_ = cvt_pk_bf16(P[B_+6], P[B_+7]); \
        auto r0 = __builtin_amdgcn_permlane32_swap(a0, b0_, false, false); auto r1 = __builtin_amdgcn_permlane32_swap(a1, b1_, false, false); \
        u32x4 w = {r0[0], r1[0], r0[1], r1[1]}; OUT = __builtin_bit_cast(bf16x8, w); } while (0)
        PK4(p0, 0, pa0); PK4(p0, 8, pa1); PK4(p1, 0, pa2); PK4(p1, 8, pa3);
#undef PK4
        if (VAR != 3 && t + 1 < NT) ATT_WRITE(buf ^ 1);
        if (VAR == 4) { asm volatile("" :: "v"(pa0), "v"(pa1), "v"(pa2), "v"(pa3)); }
        else { const LAS char* vp = vp0 + buf * G::VBUF;
          s16x4 la[4], ha[4], lb[4], hb[4];
#define VLOAD(L, H, d0) do { _Pragma("unroll") for (int ks = 0; ks < 4; ++ks) { L[ks] = vtr(vp + (d0) * 512 + ks * 4096); H[ks] = vtr(vp + (d0) * 512 + ks * 4096 + 2048); } } while (0)
#define VF(L, H, k) (bf16x8){L[k][0], L[k][1], L[k][2], L[k][3], H[k][0], H[k][1], H[k][2], H[k][3]}
#define VMMA(L, H, d0) do { o[d0] = __builtin_amdgcn_mfma_f32_32x32x16_bf16(pa0, VF(L, H, 0), o[d0], 0, 0, 0); o[d0] = __builtin_amdgcn_mfma_f32_32x32x16_bf16(pa1, VF(L, H, 1), o[d0], 0, 0, 0); \
              o[d0] = __builtin_amdgcn_mfma_f32_32x32x16_bf16(pa2, VF(L, H, 2), o[d0], 0, 0, 0); o[d0] = __builtin_amdgcn_mfma_f32_32x32x16_bf16(pa3, VF(L, H, 3), o[d0], 0, 0, 0); } while (0)
          VLOAD(la, ha, 0);
#pragma unroll
          for (int d0 = 0; d0 < ND0; d0 += 2) {
              if (d0 + 1 < ND0) VLOAD(lb, hb, d0 + 1);
              VMMA(la, ha, d0);
              if (d0 + 2 < ND0) VLOAD(la, ha, d0 + 2);
              if (d0 + 1 < ND0) VMMA(lb, hb, d0 + 1);
          }
#undef VLOAD
#undef VF
#undef VMMA
        }
        __syncthreads();
    }
#undef ATT_LOAD
#undef ATT_WRITE
    if (hi == 0) wsf[32 + r32] = l_reg;
    float rli[16];
#pragma unroll
    for (int r = 0; r < 16; ++r) rli[r] = __builtin_amdgcn_rcpf(wsf[32 + crow(r, hi)]);
#pragma unroll
    for (int r = 0; r < 16; ++r) { const int orow = crow(r, hi);
#pragma unroll
        for (int d0 = 0; d0 < ND0; ++d0) { const float v = o[d0][r] * rli[r]; const float vn = __shfl_xor(v, 1);
            if ((r32 & 1) == 0) *(unsigned*)(ow + (size_t)orow * OP + d0 * 32 + r32) = cvt_pk_bf16(v, vn); } }
}
}

constexpr int NWAVES = 8;
constexpr size_t MiB = 1u << 20, KiB = 1u << 10;
constexpr size_t WS_CTL = 0, CTL_ZERO_BYTES = 64 * KiB;
constexpr size_t WS_META = 64 * KiB;
constexpr size_t WS_SSQ = 1 * MiB, WS_SSKV = WS_SSQ + 256 * KiB, WS_SS2 = WS_SSKV + 256 * KiB;
constexpr size_t WS_TOKE = WS_SS2 + 64 * KiB, WS_TOKPOS = WS_TOKE + 64 * KiB, WS_TOKCW = WS_TOKPOS + 128 * KiB, WS_TOKR = WS_TOKCW + 128 * KiB, WS_TOKSLOT = WS_TOKR + 64 * KiB;
constexpr size_t WS_RG = WS_TOKSLOT + 128 * KiB, WS_CWS = WS_RG + 256 * KiB, WS_WR = WS_CWS + 256 * KiB;
static_assert(WS_WR + 80 * KiB <= 4 * MiB, "small arrays");
constexpr size_t WS_ROPE = 4 * MiB, WS_VR = 3 * MiB, WS_VTOK = 6 * MiB, WS_VCW = 7 * MiB;
constexpr size_t WS_WIN = 8 * MiB, WS_WG = 12 * MiB, WS_WUQ = 16 * MiB, WS_WUKV = 17 * MiB, WS_WOUT = 18 * MiB, WS_WEI = 20 * MiB, WS_WEO = 36 * MiB, WS_WPG = 44 * MiB, WS_WPP = 46 * MiB;
constexpr size_t WS_XN = 48 * MiB, WS_PB = 80 * MiB, WS_PP = 88 * MiB, WS_QA = 120 * MiB, WS_KVA = 152 * MiB, WS_CQ = 160 * MiB, WS_CKV = 168 * MiB, WS_KR = 172 * MiB,
                 WS_Q = 174 * MiB, WS_MG = 222 * MiB, WS_XG = 120 * MiB, WS_ACT = 192 * MiB, WS_Y = 120 * MiB, WS_HB = 48 * MiB, WS_END = 256 * MiB;
static_assert(WS_Q + (size_t)T_TOK * QW * 2 <= WS_MG && WS_MG + (size_t)T_TOK * DM * 2 <= WS_END && WS_XG + (size_t)MAXSLOTS * DM * 2 <= WS_ACT && WS_ACT + (size_t)MAXSLOTS * DEXP * 2 <= WS_MG, "d_ws map");
constexpr int CW_BAR = 1024, CW_CNT = 8192;
constexpr int RING_BYTES = 131072, LDSCTL_OFF = RING_BYTES, MISC_OFF = LDSCTL_OFF + 320, LDS_BYTES = 147456;

typedef GAS unsigned gu32;
#define RLX_AGENT __ATOMIC_RELAXED, __HIP_MEMORY_SCOPE_AGENT
#define LDS_WAIT() asm volatile("s_waitcnt lgkmcnt(0)" ::: "memory")

#define XB_TMO      128
#define XB_XCNT(j)  (256  + 64 * (j))
#define XB_XSUB(j)  (1280 + 64 * (j))
#define XB_XGEN(j)  (2304 + 64 * (j))
#define XB_TOP      3328
#define XB_TOPGEN   3392
#define XCD_BAR_WORDS 3456
#define XB_SPIN_CAP (1u << 18)
__device__ __forceinline__ unsigned xb_ld(unsigned* p)              { return __hip_atomic_load(p, __ATOMIC_RELAXED, __HIP_MEMORY_SCOPE_AGENT); }
__device__ __forceinline__ unsigned xb_add(unsigned* p, unsigned v) { return __hip_atomic_fetch_add(p, v, __ATOMIC_RELAXED, __HIP_MEMORY_SCOPE_AGENT); }
__device__ __forceinline__ unsigned xb_xcc_id() { return (unsigned)__builtin_amdgcn_s_getreg((3 << 11) | 20) & 0xFu; }
#define XB_SPIN(cond, bar) do { unsigned _sp = 0; while (cond) { __builtin_amdgcn_s_sleep(1); \
    if ((++_sp & 255u) == 0u) { if (xb_ld(&(bar)[XB_TMO])) break; if (_sp > XB_SPIN_CAP) { atomicAdd(&(bar)[XB_TMO], 1u); break; } } } } while (0)
struct XcdBarrier { unsigned* bar; unsigned x; volatile LAS unsigned* st; };
__device__ __forceinline__ XcdBarrier xcd_barrier_post(unsigned* bar, volatile LAS unsigned* st) {
    XcdBarrier b; b.bar = bar; b.x = xb_xcc_id(); b.st = st;
    if (threadIdx.x == 0) (void)xb_add(&bar[XB_XCNT(b.x)], 1u);
    return b;
}
__device__ __forceinline__ void xcd_barrier_complete(unsigned* bar, unsigned x, unsigned& nloc, unsigned& nx) {
    const unsigned G = gridDim.x * gridDim.y * gridDim.z;
    unsigned sum, cnt, mine, sp = 0u;
    for (;;) {
        sum = 0u; cnt = 0u; mine = 0u;
#pragma unroll
        for (unsigned j = 0; j < 16; ++j) { const unsigned c = xb_ld(&bar[XB_XCNT(j)]); sum += c; cnt += (c > 0u) ? 1u : 0u; mine = (j == x) ? c : mine; }
        if (sum == G) break;
        __builtin_amdgcn_s_sleep(1);
        if ((++sp & 255u) == 0u) { if (xb_ld(&bar[XB_TMO])) break; if (sp > XB_SPIN_CAP) { atomicAdd(&bar[XB_TMO], 1u); break; } }
    }
    nloc = mine > 0u ? mine : 1u; nx = cnt > 0u ? cnt : 1u;
}
__device__ __forceinline__ void xcd_barrier(const XcdBarrier& b) {
    asm volatile("s_waitcnt vmcnt(0)" ::: "memory");
    __syncthreads();
    if (threadIdx.x == 0) {
        unsigned* bar = b.bar;
        __builtin_amdgcn_s_waitcnt(0);
        unsigned nloc = b.st[0], nx = b.st[1];
        if (nloc == 0u) { xcd_barrier_complete(bar, b.x, nloc, nx); b.st[0] = nloc; b.st[1] = nx; }
        const unsigned old = xb_add(&bar[XB_XSUB(b.x)], 1u);
        const unsigned gen = old / nloc;
        if (old + 1u == (gen + 1u) * nloc) {
            __builtin_amdgcn_fence(__ATOMIC_RELEASE, "agent");
            asm volatile("s_waitcnt vmcnt(0)" ::: "memory");
            const unsigned og = xb_add(&bar[XB_TOP], 1u);
            const unsigned tg = og / nx;
            if (og + 1u == (tg + 1u) * nx) xb_add(&bar[XB_TOPGEN], 1u);
            else XB_SPIN(xb_ld(&bar[XB_TOPGEN]) == tg, bar);
            __builtin_amdgcn_fence(__ATOMIC_ACQUIRE, "agent");
            xb_add(&bar[XB_XGEN(b.x)], 1u);
            asm volatile("s_waitcnt vmcnt(0)" ::: "memory");
        } else {
            XB_SPIN(xb_ld(&bar[XB_XGEN(b.x)]) == gen, bar);
            __builtin_amdgcn_fence(__ATOMIC_ACQUIRE, "agent");
            asm volatile("s_waitcnt vmcnt(0)" ::: "memory");
        }
    }
    __syncthreads();
}

__device__ __forceinline__ int pairdst(int j) { return j < 32 ? 2 * j : 2 * (j - 32) + 1; }
__device__ __forceinline__ int dst_row(int mat, int s) {
    switch (mat) {
    case 0:
        if (s < 1152) return (s & ~63) + pairdst(s & 63); if (s < 1664) return s; if (s < 1728) return 1664 + pairdst(s - 1664);
        if (s < 2752) { const int g = s - 1728; return 2048 + 256 * (g >> 7) + (g & 127); } { const int g = s - 2752; return 2048 + 256 * (g >> 7) + 128 + (g & 127); }
    case 2: { const int h = s / 192, j = s - h * 192; return j < 128 ? 128 * h + j : 1024 + 64 * h + pairdst(j - 128); }
    case 4: if (s < 256) return (s >> 7) * 256 + (s & 127); else { const int t = s - 256; return (t >> 7) * 256 + 128 + (t & 127); }
    default: return s;
    }
}
__device__ __forceinline__ void transpose_item(const float* W, int ldw, int K, int nsb, const float* gain, int mat, bf16_t* WT, LAS float* scr, int item, int lane) {
    const int kb = item / nsb, sb = item - kb * nsb, k0 = 64 * kb, s0 = 32 * sb;
    const int krow = lane >> 3, c4 = (lane & 7) * 4;
    f32x4 v[8];
#pragma unroll
    for (int i = 0; i < 8; ++i) v[i] = *(const f32x4*)(W + (size_t)(k0 + 8 * i + krow) * ldw + s0 + c4);
#pragma unroll
    for (int i = 0; i < 8; ++i) { const int kk = 8 * i + krow; const float gg = gain ? gain[k0 + kk] : 1.f; LAS float* d = scr + kk * 33 + c4;
        d[0] = v[i][0] * gg; d[1] = v[i][1] * gg; d[2] = v[i][2] * gg; d[3] = v[i][3] * gg; }
    LDS_WAIT(); asm volatile("" ::: "memory");
    const int c = lane & 7;
#pragma unroll
    for (int j = 0; j < 4; ++j) { const int n = (lane >> 3) + 8 * j; const LAS float* sp = scr + (8 * c) * 33 + n;
        u32x4 o; o.x = cvt_pk_bf16(sp[0 * 33], sp[1 * 33]); o.y = cvt_pk_bf16(sp[2 * 33], sp[3 * 33]); o.z = cvt_pk_bf16(sp[4 * 33], sp[5 * 33]); o.w = cvt_pk_bf16(sp[6 * 33], sp[7 * 33]);
        *(u32x4*)(WT + (size_t)dst_row(mat, s0 + n) * K + k0 + 8 * c) = o; }
    LDS_WAIT(); asm volatile("" ::: "memory");
}
__device__ __forceinline__ void sincos_d(float ang, float& c, float& s) {
    const double x = (double)ang, q = __builtin_rint(x * 0.63661977236758134308);
    double r = __builtin_fma(-q, 1.5707963267948966, x); r = __builtin_fma(-q, 6.123233995736766e-17, r);
    const double r2 = r * r;
    double sp = -1.0 / 1307674368000.0; sp = sp * r2 + 1.0 / 6227020800.0; sp = sp * r2 - 1.0 / 39916800.0; sp = sp * r2 + 1.0 / 362880.0; sp = sp * r2 - 1.0 / 5040.0; sp = sp * r2 + 1.0 / 120.0; sp = sp * r2 - 1.0 / 6.0; sp = sp * r2 + 1.0;
    const double sr = sp * r;
    double cp = 1.0 / 20922789888000.0; cp = cp * r2 - 1.0 / 87178291200.0; cp = cp * r2 + 1.0 / 479001600.0; cp = cp * r2 - 1.0 / 3628800.0; cp = cp * r2 + 1.0 / 40320.0; cp = cp * r2 - 1.0 / 720.0; cp = cp * r2 + 1.0 / 24.0; cp = cp * r2 - 0.5; cp = cp * r2 + 1.0;
    const int n = ((int)q) & 3;
    const double cc = (n == 0) ? cp : (n == 1) ? -sr : (n == 2) ? -cp : sr;
    const double ss = (n == 0) ? sr : (n == 1) ? cp : (n == 2) ? -sr : -cp;
    c = (float)cc; s = (float)ss;
}

typedef const __attribute__((address_space(4))) char* kptr_t;
__device__ __forceinline__ kptr_t kargp() { kptr_t p = (kptr_t)__builtin_amdgcn_kernarg_segment_ptr(); asm volatile("" : "+s"(p)); return p; }
template <class T> __device__ __forceinline__ T karg(kptr_t kp, int off) { return *(const __attribute__((address_space(4))) T*)(kp + off); }
#define KP_INIT kptr_t kp_ = kargp(); unsigned char* ws = karg<unsigned char*>(kp_, 176); (void)ws;
#define INP(i) karg<const float*>(kp_, 8 * (i))
#define OUTP karg<float*>(kp_, 168)
#define WSP(T, off) ((T*)(ws + (off)))
struct Args { const float* in[21]; float* out; unsigned char* ws; int ph_lo, ph_hi; };
constexpr int NPHASE = 13;

__global__ void __launch_bounds__(NWAVES * 64, 2) mk_fwd(Args) {
    extern __shared__ __attribute__((aligned(16))) unsigned char lds_raw[];
    LAS unsigned char* lds = (LAS unsigned char*)lds_raw;
    volatile LAS unsigned* MISC = (volatile LAS unsigned*)(lds + MISC_OFF);
    const int G = gridDim.x, bx = blockIdx.x, vcu = (G % 8 == 0) ? (bx % 8) * (G / 8) + bx / 8 : bx;
    const int NGW = G * NWAVES;
#define PH_IDS const int tid = opaque_tid(), lane = tid & 63, wave = __builtin_amdgcn_readfirstlane(tid >> 6), gw = vcu * NWAVES + wave; (void)lane; (void)gw;
    gu32* ctl; { KP_INIT ctl = (gu32*)(ws + WS_CTL); }
    { PH_IDS for (int u = tid; u < (LDS_BYTES - LDSCTL_OFF) / 4; u += NWAVES * 64) ((LAS unsigned*)(lds + LDSCTL_OFF))[u] = 0u; }
    __syncthreads();
    XcdBarrier bar; bar.bar = (unsigned*)(ctl + CW_BAR); bar.x = 0; bar.st = nullptr;
#if MK_ONE_LAUNCH
    bar = xcd_barrier_post((unsigned*)(ctl + CW_BAR), MISC + 8);
#define GRID_BAR() xcd_barrier(bar)
#else
#define GRID_BAR() do {} while (0)
#endif
    int lo, hi_ph; { KP_INIT lo = karg<int>(kp_, 184); hi_ph = karg<int>(kp_, 188); }
#ifndef PH_MASK
#define PH_MASK 0x1fff
#endif
#define IN(k) ((((PH_MASK) >> (k)) & 1) && lo <= (k) && (k) < hi_ph)
    unsigned long long t_p0 = 0, t_p1 = 0;
#define SEAM(k) do { if (IN(k) && IN((k) + 1)) GRID_BAR(); if ((k) == PROBE_HI) t_p1 = __builtin_amdgcn_s_memrealtime(); if ((k) + 1 == PROBE_LO) t_p0 = __builtin_amdgcn_s_memrealtime(); } while (0)

    if (PROBE_LO == 0) t_p0 = __builtin_amdgcn_s_memrealtime();
    if (IN(0)) { PH_IDS
        KP_INIT const float* x = INP(0); const float* p_in = INP(1); const float* g_mix = INP(2); const float* w_in = INP(3); const float* g_q = INP(5); const float* w_uq = INP(6); const float* g_kv = INP(7); const float* w_ukv = INP(8); const float* w_out = INP(9);
        const float* g_ffn = INP(10); const float* w_rg = INP(11); const float* w_re = INP(13); const float* w_ei = INP(15); const float* w_eo = INP(16); const float* g_ple = INP(17); const float* w_pg = INP(18); const float* w_pp = INP(19);
        bf16_t* Win_t = WSP(bf16_t, WS_WIN); bf16_t* Wg_t = WSP(bf16_t, WS_WG); bf16_t* Wuq_t = WSP(bf16_t, WS_WUQ); bf16_t* Wukv_t = WSP(bf16_t, WS_WUKV); bf16_t* Wout_t = WSP(bf16_t, WS_WOUT); bf16_t* Wei_t = WSP(bf16_t, WS_WEI);
        bf16_t* Weo_t = WSP(bf16_t, WS_WEO); bf16_t* Wpg_t = WSP(bf16_t, WS_WPG); bf16_t* Wpp_t = WSP(bf16_t, WS_WPP); bf16_t* XN = WSP(bf16_t, WS_XN); bf16_t* PB = WSP(bf16_t, WS_PB); float* WR = WSP(float, WS_WR); float* ROPE = WSP(float, WS_ROPE);
        LAS float* scr = (LAS float*)(lds + wave * 16384);
        constexpr int I_IN = 16 * 118, I_UQ = 4 * 48, I_UKV = 2 * 64, I_OUT = 16 * 32, I_EI1 = 16 * 16, I_EI = NEXP * I_EI1, I_EO1 = 4 * 32, I_EO = NEXP * I_EO1, I_PG = 16 * 32, I_PP = 4 * 32;
        constexpr int NITEMS = I_IN + I_UQ + I_UKV + I_OUT + I_EI + I_EO + I_PG + I_PP;
        (void)Wg_t;
        static_assert(WS_WG - WS_WIN == 2048 * 1024 * 2, "gate weights sit 2048 rows above Win_t");
        for (int it = gw; it < NITEMS; it += NGW) {
            int r = it;
            if (r < I_IN) { transpose_item(w_in, 3776, 1024, 118, nullptr, 0, Win_t, scr, r, lane); continue; } r -= I_IN;
            if (r < I_UQ) { transpose_item(w_uq, QW, 256, 48, g_q, 2, Wuq_t, scr, r, lane); continue; } r -= I_UQ;
            if (r < I_UKV) { transpose_item(w_ukv, KVW, 128, 64, g_kv, 3, Wukv_t, scr, r, lane); continue; } r -= I_UKV;
            if (r < I_OUT) { transpose_item(w_out, 1024, 1024, 32, nullptr, 3, Wout_t, scr, r, lane); continue; } r -= I_OUT;
            if (r < I_EI) { const int e = r / I_EI1; transpose_item(w_ei + (size_t)e * 1024 * 512, 512, 1024, 16, g_ffn, 4, Wei_t + (size_t)e * 512 * 1024, scr, r % I_EI1, lane); continue; } r -= I_EI;
            if (r < I_EO) { const int e = r / I_EO1; transpose_item(w_eo + (size_t)e * 256 * 1024, 1024, 256, 32, nullptr, 3, Weo_t + (size_t)e * 1024 * 256, scr, r % I_EO1, lane); continue; } r -= I_EO;
            if (r < I_PG) { transpose_item(w_pg, 1024, 1024, 32, g_ple, 3, Wpg_t, scr, r, lane); continue; } r -= I_PG;
            transpose_item(w_pp, 1024, 256, 32, nullptr, 3, Wpp_t, scr, r, lane);
        }
        for (int e = bx * (NWAVES * 64) + tid; e < 64 * 1024 / 8; e += G * NWAVES * 64) *((u32x4*)(Win_t + (size_t)1728 * 1024) + e) = (u32x4){0u, 0u, 0u, 0u};
        { f32x4 gg[4];
#pragma unroll
          for (int j = 0; j < 4; ++j) gg[j] = *((const f32x4*)g_mix + lane + 64 * j);
          for (int m0 = gw; m0 < T_TOK; m0 += 2 * NGW) {
            f32x4 v[2][4], pv[2];
#pragma unroll
            for (int q = 0; q < 2; ++q) { const int m = m0 + q * NGW < T_TOK ? m0 + q * NGW : m0; const f32x4* xr = (const f32x4*)(x + (size_t)m * DM) + lane;
#pragma unroll
                for (int j = 0; j < 4; ++j) v[q][j] = xr[64 * j];
                pv[q] = *((const f32x4*)(p_in + (size_t)m * 256) + lane); }
#pragma unroll
            for (int q = 0; q < 2; ++q) { const int m = m0 + q * NGW; if (m >= T_TOK) break; float s = 0.f;
#pragma unroll
                for (int j = 0; j < 4; ++j) s += (v[q][j].x * v[q][j].x + v[q][j].y * v[q][j].y) + (v[q][j].z * v[q][j].z + v[q][j].w * v[q][j].w);
                const float rs = __builtin_amdgcn_rsqf(wave_sum(s) * (1.f / DM) + EPS);
                u32x2* o8 = (u32x2*)(XN + (size_t)m * DM) + lane;
#pragma unroll
                for (int j = 0; j < 4; ++j) { u32x2 w; w.x = cvt_pk_bf16(v[q][j].x * rs * gg[j].x, v[q][j].y * rs * gg[j].y); w.y = cvt_pk_bf16(v[q][j].z * rs * gg[j].z, v[q][j].w * rs * gg[j].w); o8[64 * j] = w; }
                u32x2 w; w.x = cvt_pk_bf16(pv[q].x, pv[q].y); w.y = cvt_pk_bf16(pv[q].z, pv[q].w);
                *((u32x2*)(PB + (size_t)m * 256) + lane) = w; }
          } }
        for (int e = bx * (NWAVES * 64) + tid; e < SEQ * 32; e += G * NWAVES * 64) {
            const int pos = e >> 5, i = e & 31; const float inv = powf(10000.f, -(float)(2 * i) / 64.f); const float ang = (float)pos * inv;
            float c, s; sincos_d(ang, c, s); *(f32x2*)(ROPE + (size_t)e * 2) = (f32x2){c, s};
        }
        for (int e = bx * (NWAVES * 64) + tid; e < 20 * 1024; e += G * NWAVES * 64) {
            const int j = e >> 10, k = e & 1023; WR[e] = g_ffn[k] * (j < 4 ? w_rg[k * 4 + j] : w_re[k * 16 + (j - 4)]);
        }
    }
    SEAM(0);
    if (IN(1)) {
        KP_INIT bf16_t* XN = WSP(bf16_t, WS_XN); bf16_t* Win_t = WSP(bf16_t, WS_WIN); bf16_t* PB = WSP(bf16_t, WS_PB); bf16_t* Wpp_t = WSP(bf16_t, WS_WPP); bf16_t* PP = WSP(bf16_t, WS_PP); bf16_t* QA = WSP(bf16_t, WS_QA); bf16_t* KVA = WSP(bf16_t, WS_KVA);
        bf16_t* CQ = WSP(bf16_t, WS_CQ); bf16_t* CKV = WSP(bf16_t, WS_CKV); bf16_t* KR = WSP(bf16_t, WS_KR); float* SSQ = WSP(float, WS_SSQ); float* SSKV = WSP(float, WS_SSKV); float* ROPE = WSP(float, WS_ROPE);
        { pg8::Gemm g{XN, Win_t, 1024}; pg8::StaticOrder S; S.init(T_TOK, N1, G, bx);
          pg8::EpiIn E{QA, KVA, CQ, CKV, KR, SSQ, SSKV, ROPE}; pg8::gemm_phase(lds, g, S, E); }
        if (bx >= G - 64) { pg8::Gemm g{PB, Wpp_t, 256}; pg8::StaticOrder S; S.init(T_TOK, 1024, 64, bx - (G - 64));
          pg8::EpiRows E{PP, DM, nullptr, 0.f, 1.f, 1 << 30, nullptr}; pg8::gemm_phase(lds, g, S, E); }
    }
    SEAM(1);
    if (IN(2)) { PH_IDS
        KP_INIT const float* sinks = INP(4); bf16_t* CQ = WSP(bf16_t, WS_CQ); bf16_t* CKV = WSP(bf16_t, WS_CKV); bf16_t* Wuq_t = WSP(bf16_t, WS_WUQ); bf16_t* Wukv_t = WSP(bf16_t, WS_WUKV); bf16_t* Qm = WSP(bf16_t, WS_Q); bf16_t* KVm = (bf16_t*)OUTP;
        bf16_t* QA = WSP(bf16_t, WS_QA); bf16_t* KVA = WSP(bf16_t, WS_KVA); float* SSQ = WSP(float, WS_SSQ); float* SSKV = WSP(float, WS_SSKV); float* ROPE = WSP(float, WS_ROPE);
        { pg8::Gemm g{CQ, Wuq_t, 256}; pg8::StaticOrder S; S.init(T_TOK, QW, G, bx);
          pg8::EpiRows E{Qm, QW, SSQ, 1.f / 256.f, C2MLA, 4, ROPE}; pg8::gemm_phase(lds, g, S, E); }
        { pg8::Gemm g{CKV, Wukv_t, 128}; pg8::StaticOrder S; S.init(T_TOK, KVW, G, bx);
          pg8::EpiRows E{KVm, KVW, SSKV, 1.f / 128.f, 1.f, 1 << 30, nullptr}; pg8::gemm_phase(lds, g, S, E); }
        for (int uidx = vcu; uidx < 2 * 2 * 256; uidx += G) {
            const int pblk = uidx & 255, kvh = (uidx >> 8) & 1, b = uidx >> 9;
            const int h = kvh * 8 + wave, pos0 = pblk * 32; const size_t rowb = (size_t)b * SEQ;
            const int lowk = pos0 - 127; const int j_lo = lowk > 0 ? lowk / 64 : 0, j_hi = (pos0 + 31) / 64 + 1;
            const bf16_t* qp = QA + (rowb + pos0) * DM + h * 64;
            att::attn_unit<64, 64, 64>((LAS char*)lds, qp, qp, DM, KVA + rowb * 256 + kvh * 64, 256, nullptr, 0, KVA + rowb * 256 + 128 + kvh * 64, 256,
                                       j_lo, j_hi, pos0, 128u, sinks[h] * LOG2E, 1.f, QA + (rowb + pos0) * DM + h * 64, DM);
        }
    }
    SEAM(2);
#if PROBE_ATT >= 0
    {   PH_IDS KP_INIT bf16_t* Qm = WSP(bf16_t, WS_Q); bf16_t* KVm = (bf16_t*)OUTP; bf16_t* KR = WSP(bf16_t, WS_KR); bf16_t* MG = WSP(bf16_t, WS_MG);
        t_p0 = __builtin_amdgcn_s_memrealtime();
        for (int pi = vcu; pi < 256; pi += G) {
            const int bh = pi >> 4, s = pi & 15, b = bh >> 3, h = bh & 7; const size_t rowb = (size_t)b * SEQ;
            for (int pass = 0; pass < 2; ++pass) {
                const int qb = pass == 0 ? 31 - s : s, q0 = qb * 256 + wave * 32;
                const bf16_t* q1 = Qm + (rowb + q0) * QW + h * 128; const bf16_t* q2 = Qm + (rowb + q0) * QW + 1024 + h * 64;
                att::attn_unit<192, 128, 128, PROBE_ATT>((LAS char*)lds, q1, q2, QW, KVm + rowb * KVW + h * 256, KVW, KR + rowb * 64, 64, KVm + rowb * KVW + h * 256 + 128, KVW,
                                              0, (qb + 1) * 4, q0, 1u << 30, -1e30f, 0.f, MG + (rowb + q0) * DM + h * 128, DM);
            }
        }
        GRID_BAR(); t_p1 = __builtin_amdgcn_s_memrealtime();
    }
#endif
    if (IN(3)) { PH_IDS
        KP_INIT bf16_t* Qm = WSP(bf16_t, WS_Q); bf16_t* KVm = (bf16_t*)OUTP; bf16_t* KR = WSP(bf16_t, WS_KR);
        for (int pi = vcu; pi < 256; pi += G) {
            const int bh = pi >> 4, s = pi & 15, b = bh >> 3, h = bh & 7; const size_t rowb = (size_t)b * SEQ;
            for (int pass = 0; pass < 2; ++pass) {
                const int qb = pass == 0 ? 31 - s : s, q0 = qb * 256 + wave * 32;
                const bf16_t* q1 = Qm + (rowb + q0) * QW + h * 128; const bf16_t* q2 = Qm + (rowb + q0) * QW + 1024 + h * 64;
                att::attn_unit<192, 128, 128>((LAS char*)lds, q1, q2, QW, KVm + rowb * KVW + h * 256, KVW, KR + rowb * 64, 64, KVm + rowb * KVW + h * 256 + 128, KVW,
                                              0, (qb + 1) * 4, q0, 1u << 30, -1e30f, 0.f, Qm + (rowb + q0) * QW + h * 128, QW);
            }
        }
    }
    SEAM(3);
    if (IN(4)) {
        KP_INIT bf16_t* XN = WSP(bf16_t, WS_XN); bf16_t* Wg_t = WSP(bf16_t, WS_WG); bf16_t* QA = WSP(bf16_t, WS_QA); bf16_t* Qm = WSP(bf16_t, WS_Q); bf16_t* MG = WSP(bf16_t, WS_MG);
        pg8::Gemm g{XN, Wg_t, 1024}; pg8::StaticOrder S; S.init(T_TOK, NGATE, G, bx);
        pg8::EpiGate E{QA, Qm, QW, MG}; pg8::gemm_phase(lds, g, S, E);
    }
    SEAM(4);
    if (IN(5)) {
        KP_INIT const float* x = INP(0); float* out = OUTP; bf16_t* MG = WSP(bf16_t, WS_MG); bf16_t* Wout_t = WSP(bf16_t, WS_WOUT); bf16_t* HB = WSP(bf16_t, WS_HB);
        pg8::Gemm g{MG, Wout_t, 1024}; pg8::StaticOrder S; S.init(T_TOK, 1024, G, bx);
        pg8::EpiRes E{x, out, HB}; pg8::gemm_phase(lds, g, S, E);
    }
    SEAM(5);
    if (IN(6)) { PH_IDS
        KP_INIT const float* b_rg = INP(12); const float* b_re = INP(14); float* out = OUTP; float* WR = WSP(float, WS_WR); int* TOKE = WSP(int, WS_TOKE); int* TOKPOS = WSP(int, WS_TOKPOS);
        int* VTOK = WSP(int, WS_VTOK); float* VCW = WSP(float, WS_VCW); float* VR = WSP(float, WS_VR);
        LAS float* wl = (LAS float*)lds;
        for (int i = tid; i < 20 * 256; i += NWAVES * 64) ((LAS f32x4*)wl)[i] = ((const f32x4*)WR)[i];
        __syncthreads();
        LAS int* rec_e = (LAS int*)(lds + 81920); LAS float* rec_f = (LAS float*)(lds + 81920 + 256); int jrow = 0;
        f32x4 vn[4];
        if (gw < T_TOK) { const f32x4* hr = (const f32x4*)(out + (size_t)gw * DM) + lane;
#pragma unroll
            for (int j = 0; j < 4; ++j) vn[j] = hr[64 * j]; }
        for (int m = gw; m < T_TOK; m += NGW) {
            f32x4 v[4]; float s = 0.f;
#pragma unroll
            for (int j = 0; j < 4; ++j) { v[j] = vn[j]; s += (v[j].x * v[j].x + v[j].y * v[j].y) + (v[j].z * v[j].z + v[j].w * v[j].w); }
            { const int mn = m + NGW < T_TOK ? m + NGW : m; const f32x4* hr = (const f32x4*)(out + (size_t)mn * DM) + lane;
#pragma unroll
              for (int j = 0; j < 4; ++j) vn[j] = hr[64 * j]; }
            const float r2 = __builtin_amdgcn_rsqf(wave_sum(s) * (1.f / DM) + EPS);
            float lg[20];
#pragma unroll
            for (int c = 0; c < 20; ++c) { float d = 0.f;
#pragma unroll
                for (int j = 0; j < 4; ++j) { const f32x4 w = ((const LAS f32x4*)wl)[c * 256 + 64 * j + lane]; d += (v[j].x * w.x + v[j].y * w.y) + (v[j].z * w.z + v[j].w * w.w); }
                lg[c] = wave_sum(d) * r2; if ((c & 3) == 3) asm volatile("" ::: "memory"); }
#pragma unroll
            for (int c = 0; c < 4; ++c) lg[c] += b_rg[c];
#pragma unroll
            for (int c = 0; c < 16; ++c) lg[4 + c] += b_re[c];
            int gi = 0; float gm = lg[0];
#pragma unroll
            for (int c = 1; c < 4; ++c) if (lg[c] > gm) { gm = lg[c]; gi = c; }
            float gs = 0.f;
#pragma unroll
            for (int c = 0; c < 4; ++c) gs += __expf(lg[c] - gm);
            const float g_w = 1.f / gs;
            float es[4];
#pragma unroll
            for (int k = 0; k < 4; ++k) es[k] = gi == 0 ? lg[4 + k] : gi == 1 ? lg[8 + k] : gi == 2 ? lg[12 + k] : lg[16 + k];
            int i0 = 0; float e0 = es[0];
#pragma unroll
            for (int k = 1; k < 4; ++k) if (es[k] > e0) { e0 = es[k]; i0 = k; }
            int i1 = -1; float e1 = -__builtin_inff();
#pragma unroll
            for (int k = 0; k < 4; ++k) if (k != i0 && es[k] > e1) { e1 = es[k]; i1 = k; }
            const float t1 = __expf(e1 - e0), w0 = 1.f / (1.f + t1), w1 = t1 * w0;
            if (lane == 0) { const int lr = wave * 8 + jrow; rec_e[lr] = (gi * 4 + i0) | ((gi * 4 + i1) << 8); rec_f[lr] = w0 * g_w; rec_f[64 + lr] = w1 * g_w; rec_f[128 + lr] = r2; }
            ++jrow;
        }
        __syncthreads();
        if (wave == 0) {
            const int lr = lane, jr = lr & 7, wv = lr >> 3, m = vcu * NWAVES + wv + jr * NGW;
            const bool valid = m < T_TOK;
            const int ee = valid ? rec_e[lr] : 0xffff, ex0 = ee & 255, ex1 = (ee >> 8) & 255;
            const unsigned long long lt = (1ull << lane) - 1ull;
            int rank0 = 0, rank1 = 0; unsigned myc = 0u;
#pragma unroll
            for (int e = 0; e < NEXP; ++e) { const unsigned long long b0 = __ballot(ex0 == e), b1 = __ballot(ex1 == e); const int c0 = __popcll(b0);
                if (ex0 == e) rank0 = __popcll(b0 & lt); if (ex1 == e) rank1 = c0 + __popcll(b1 & lt);
                if (lane == e) myc = (unsigned)(c0 + __popcll(b1)); }
            unsigned base = 0u; if (lane < NEXP && myc) base = __hip_atomic_fetch_add(ctl + CW_CNT + 64 * lane, myc, RLX_AGENT);
            const int p0 = (int)__shfl((int)base, ex0 & 15) + rank0, p1 = (int)__shfl((int)base, ex1 & 15) + rank1;
            if (valid) { TOKE[m] = ee; TOKPOS[2 * m] = p0; TOKPOS[2 * m + 1] = p1;
                VTOK[ex0 * 16384 + p0] = m; VTOK[ex1 * 16384 + p1] = m; VCW[ex0 * 16384 + p0] = rec_f[lr]; VCW[ex1 * 16384 + p1] = rec_f[64 + lr];
                const float r2 = rec_f[128 + lr]; VR[ex0 * 16384 + p0] = r2; VR[ex1 * 16384 + p1] = r2; }
        }
    }
    SEAM(6);
    if (IN(8)) {
        KP_INIT bf16_t* HB = WSP(bf16_t, WS_HB); bf16_t* Wei_t = WSP(bf16_t, WS_WEI); bf16_t* ACT = WSP(bf16_t, WS_ACT); int* VTOK = WSP(int, WS_VTOK); float* VCW = WSP(float, WS_VCW); float* VR = WSP(float, WS_VR);
        pg8::Gemm g{HB, Wei_t, 1024}; pg8::GroupedOrder S; S.init((const unsigned*)(ctl + CW_CNT), 2, G, bx);
        pg8::EpiMoeIn E{VR, VCW, ACT}; pg8::gemm_phase<true>(lds, g, S, E, VTOK);
    }
    SEAM(8);
    if (IN(9)) {
        KP_INIT bf16_t* ACT = WSP(bf16_t, WS_ACT); bf16_t* Weo_t = WSP(bf16_t, WS_WEO); bf16_t* Y = WSP(bf16_t, WS_Y);
        pg8::Gemm g{ACT, Weo_t, 256}; pg8::GroupedOrder S; S.init((const unsigned*)(ctl + CW_CNT), 4, G, bx);
        pg8::EpiRows E{Y, DM, nullptr, 0.f, 1.f, 1 << 30, nullptr}; pg8::gemm_phase(lds, g, S, E);
    }
    SEAM(9);
    if (IN(10)) { PH_IDS
        KP_INIT float* out = OUTP; bf16_t* Y = WSP(bf16_t, WS_Y); bf16_t* HB = WSP(bf16_t, WS_HB); int* TOKE = WSP(int, WS_TOKE); int* TOKPOS = WSP(int, WS_TOKPOS); float* SS2 = WSP(float, WS_SS2);
        int off[NEXP]; { int tot = 0;
#pragma unroll
          for (int e = 0; e < NEXP; ++e) { const int c = (int)__builtin_amdgcn_readfirstlane(__hip_atomic_load(ctl + CW_CNT + 64 * e, RLX_AGENT)); off[e] = tot; tot += (c + 255) >> 8; } }
        for (int m = gw; m < T_TOK; m += NGW) {
            const int ee = __builtin_amdgcn_readfirstlane(TOKE[m]), ex0 = ee & 255, ex1 = ee >> 8; int o0 = 0, o1 = 0;
#pragma unroll
            for (int e = 0; e < NEXP; ++e) { o0 = (e == ex0) ? off[e] : o0; o1 = (e == ex1) ? off[e] : o1; }
            const int s0 = o0 * 256 + __builtin_amdgcn_readfirstlane(TOKPOS[2 * m]), s1 = o1 * 256 + __builtin_amdgcn_readfirstlane(TOKPOS[2 * m + 1]);
            f32x4* hr = (f32x4*)(out + (size_t)m * DM) + lane; const u32x2* y0 = (const u32x2*)(Y + (size_t)s0 * DM) + lane; const u32x2* y1 = (const u32x2*)(Y + (size_t)s1 * DM) + lane;
            u32x2* hb = (u32x2*)(HB + (size_t)m * DM) + lane; float s = 0.f;
#pragma unroll
            for (int j = 0; j < 4; ++j) { f32x4 v = hr[64 * j]; const u32x2 a = y0[64 * j], b2 = y1[64 * j];
                v.x += bf_lo(a.x) + bf_lo(b2.x); v.y += bf_hi(a.x) + bf_hi(b2.x); v.z += bf_lo(a.y) + bf_lo(b2.y); v.w += bf_hi(a.y) + bf_hi(b2.y);
                s += (v.x * v.x + v.y * v.y) + (v.z * v.z + v.w * v.w); hr[64 * j] = v;
                u32x2 w; w.x = cvt_pk_bf16(v.x, v.y); w.y = cvt_pk_bf16(v.z, v.w); hb[64 * j] = w; }
            s = wave_sum(s); if (lane == 0) SS2[m] = s;
        }
    }
    SEAM(10);
    if (IN(11)) {
        KP_INIT float* out = OUTP; bf16_t* HB = WSP(bf16_t, WS_HB); bf16_t* Wpg_t = WSP(bf16_t, WS_WPG); bf16_t* PP = WSP(bf16_t, WS_PP); float* SS2 = WSP(float, WS_SS2);
        pg8::Gemm g{HB, Wpg_t, 1024}; pg8::StaticOrder S; S.init(T_TOK, 1024, G, bx);
        pg8::EpiPle E{out, PP, SS2}; pg8::gemm_phase(lds, g, S, E);
    }
    SEAM(11);
    if (IN(12)) { PH_IDS
        KP_INIT float* out = OUTP; const float* g_fin = INP(20);
        for (int m = gw; m < T_TOK; m += NGW) {
            f32x4* hr = (f32x4*)(out + (size_t)m * DM) + lane; f32x4 v[4]; float s = 0.f;
#pragma unroll
            for (int j = 0; j < 4; ++j) { v[j] = hr[64 * j]; s += (v[j].x * v[j].x + v[j].y * v[j].y) + (v[j].z * v[j].z + v[j].w * v[j].w); }
            const float rs = __builtin_amdgcn_rsqf(wave_sum(s) * (1.f / DM) + EPS);
#pragma unroll
            for (int j = 0; j < 4; ++j) { const f32x4 gg = *((const f32x4*)g_fin + lane + 64 * j); hr[64 * j] = (f32x4){v[j].x * rs * gg.x, v[j].y * rs * gg.y, v[j].z * rs * gg.z, v[j].w * rs * gg.w}; }
        }
    }
    if (PROBE_LO >= 0 || PROBE_ATT >= 0) { if (PROBE_HI == NPHASE - 1) t_p1 = __builtin_amdgcn_s_memrealtime();
        if (bx == 0) { const unsigned long long te = __builtin_amdgcn_s_memrealtime(), d = (t_p1 - t_p0) * PROBE_MUL; while (__builtin_amdgcn_s_memrealtime() - te < d) __builtin_amdgcn_s_sleep(8); } }
#undef IN
#undef SEAM
#undef GRID_BAR
}

extern "C" void kernel_launch(void* const* d_in, const int* in_sizes, int n_in, void* d_out, int out_size, void* d_ws, size_t ws_size, hipStream_t stream) {
    static int grid = 0;
    if (grid == 0) {
        if (n_in != 21 || in_sizes[0] != T_TOK * DM || out_size != T_TOK * DM || ws_size < WS_END) { fprintf(stderr, "kernel_launch: unexpected shapes (n_in %d, in0 %d, out %d, ws %zu)\n", n_in, n_in > 0 ? in_sizes[0] : -1, out_size, ws_size); grid = -1; return; }
        int dev = 0, cus = 0, per_cu = 0;
        if (hipGetDevice(&dev) != hipSuccess || hipDeviceGetAttribute(&cus, hipDeviceAttributeMultiprocessorCount, dev) != hipSuccess) { grid = -1; return; }
        if (hipFuncSetAttribute((const void*)mk_fwd, hipFuncAttributeMaxDynamicSharedMemorySize, LDS_BYTES) != hipSuccess) { fprintf(stderr, "kernel_launch: hipFuncSetAttribute failed\n"); grid = -1; return; }
        if (hipOccupancyMaxActiveBlocksPerMultiprocessor(&per_cu, (const void*)mk_fwd, NWAVES * 64, LDS_BYTES) != hipSuccess || per_cu < 1) { fprintf(stderr, "kernel_launch: occupancy query says %d blocks per CU\n", per_cu); (void)hipGetLastError(); grid = -1; return; }
        grid = cus;
    }
    if (grid < 0) return;
    (void)hipMemsetAsync((char*)d_ws + WS_CTL, 0, CTL_ZERO_BYTES, stream);
    Args a{};
    for (int i = 0; i < 21; ++i) a.in[i] = (const float*)d_in[i];
    a.out = (float*)d_out; a.ws = (unsigned char*)d_ws;
#if MK_ONE_LAUNCH
    a.ph_lo = 0; a.ph_hi = NPHASE;
    hipLaunchKernelGGL(mk_fwd, dim3(grid), dim3(NWAVES * 64), LDS_BYTES, stream, a);
#else
    for (int ph = 0; ph < NPHASE; ++ph) { a.ph_lo = ph; a.ph_hi = ph + 1; hipLaunchKernelGGL(mk_fwd, dim3(grid), dim3(NWAVES * 64), LDS_BYTES, stream, a); }
#endif
}
```
